# Optimizing an MI355X kernel written in HIP

```python
import jax, jax.numpy as jnp
from jax import lax
import numpy as np

D_MODEL = 1024
BATCH = 4
SEQ = 8192
DEPTH = 2

GRID_W = 64
CTX_LEN = 256
Q_BLOCK = 128
ROPE_THETA = 10000.0
EPS = 1e-6
N_MOD = 6
MLA_HEADS = 8
MLA_NOPE = 64
MLA_ROPE = 32
MLA_V = 64
MLA_Q_RANK = 384
MLA_KV_RANK = 256
POOL_WINDOWS = (2, 4, 8, 16)
POOL_WIDTH = 512
POOL_GROUP = POOL_WIDTH // len(POOL_WINDOWS)
MIX0_IN = MLA_Q_RANK + MLA_KV_RANK + MLA_ROPE + POOL_WIDTH
MIX0_OUT = MLA_HEADS * MLA_V + POOL_WIDTH
GQA_HEADS = 8
GQA_KV_HEADS = 2
GQA_HEAD_DIM = 128
GQA_GROUP = GQA_HEADS // GQA_KV_HEADS
GQA_Q_W = GQA_HEADS * GQA_HEAD_DIM
GQA_KV_W = GQA_KV_HEADS * GQA_HEAD_DIM
D_FF = 2816
CONV_W = 3
N_EVEN = (DEPTH + 1) // 2
N_ODD = DEPTH // 2

kernel_name = 'hybrid_mla_pool_gqa_convffn_dit'


def rms_norm(x, gain=None):
    xf = x.astype(jnp.float32)
    y = (xf * lax.rsqrt(jnp.mean(xf * xf, axis=-1, keepdims=True) + EPS)).astype(x.dtype)
    return y if gain is None else y * gain


def modulate(x, shift, scale):
    return rms_norm(x) * (1.0 + scale) + shift


def axial_rope_tables(n_tokens, rope_dim):
    rows = n_tokens // GRID_W
    row = jnp.repeat(jnp.arange(rows, dtype=jnp.float32), GRID_W)
    col = jnp.tile(jnp.arange(GRID_W, dtype=jnp.float32), rows)
    n_freq = rope_dim // 4
    freq = ROPE_THETA ** (-jnp.arange(n_freq, dtype=jnp.float32) / n_freq)
    ang = jnp.concatenate([row[:, None] * freq, col[:, None] * freq], axis=-1)
    return jnp.cos(ang), jnp.sin(ang)


def apply_rope(x, cos, sin):
    xr = x.reshape(x.shape[:-1] + (x.shape[-1] // 2, 2))
    x0, x1 = xr[..., 0], xr[..., 1]
    c = cos[None, :, None, :].astype(x.dtype)
    s = sin[None, :, None, :].astype(x.dtype)
    return jnp.stack([x0 * c - x1 * s, x0 * s + x1 * c], axis=-1).reshape(x.shape)


def attention(q, k, v):
    B, Nq, KV, G, Dh = q.shape
    blk = min(Q_BLOCK, Nq)
    qb = jnp.moveaxis(q.reshape(B, Nq // blk, blk, KV, G, Dh), 1, 0)
    scale = Dh ** -0.5

    def one_block(qi):
        s = jnp.einsum('bqhgd,bkhd->bhgqk', qi, k).astype(jnp.float32) * scale
        p = jax.nn.softmax(s, axis=-1).astype(v.dtype)
        return jnp.einsum('bhgqk,bkhd->bqhgd', p, v)

    o = lax.map(one_block, qb)
    return jnp.moveaxis(o, 0, 1).reshape(B, Nq, KV * G * v.shape[-1])


def multiscale_pool(p, w_pool, s_pool):
    B, T, C = p.shape
    cs = jnp.cumsum(p.astype(jnp.float32), axis=1)
    cs = jnp.concatenate([jnp.zeros((B, 1, C), jnp.float32), cs], axis=1)
    t = jnp.arange(T)
    outs = []
    for g, w in enumerate(POOL_WINDOWS):
        lo = jnp.clip(t - w // 2, 0, T)
        hi = jnp.clip(t - w // 2 + w, 0, T)
        csg = cs[:, :, g * POOL_GROUP:(g + 1) * POOL_GROUP]
        mean = (csg[:, hi] - csg[:, lo]) / (hi - lo).astype(jnp.float32)[None, :, None]
        d = mean.astype(p.dtype) - p[:, :, g * POOL_GROUP:(g + 1) * POOL_GROUP]
        outs.append(d @ w_pool[g])
    return jnp.concatenate(outs, axis=-1) * s_pool


def mla_q(cq, g_q, w_uq, cos, sin, rope):
    B, T, _ = cq.shape
    q = (rms_norm(cq, g_q) @ w_uq).reshape(B, T, MLA_HEADS, MLA_NOPE + MLA_ROPE)
    if rope:
        q = jnp.concatenate([q[..., :MLA_NOPE], apply_rope(q[..., MLA_NOPE:], cos, sin)], axis=-1)
    return q[:, :, :, None, :]


def mla_kv(ckv, kr, g_kv, w_uk, w_uv, cos, sin, rope):
    B, T, _ = ckv.shape
    ckv = rms_norm(ckv, g_kv)
    k_nope = (ckv @ w_uk).reshape(B, T, MLA_HEADS, MLA_NOPE)
    v = (ckv @ w_uv).reshape(B, T, MLA_HEADS, MLA_V)
    kr = kr[:, :, None, :]
    if rope:
        kr = apply_rope(kr, cos, sin)
    k = jnp.concatenate([k_nope, jnp.broadcast_to(kr, (B, T, MLA_HEADS, MLA_ROPE))], axis=-1)
    return k, v


def mla_pool_mixer(hc, hl, w_in, g_q, w_uq, g_kv, w_uk, w_uv, w_pool, s_pool, w_out, cos, sin, need_ctx):
    i_kv = MLA_Q_RANK
    i_kr = i_kv + MLA_KV_RANK
    i_p = i_kr + MLA_ROPE
    pl = hl @ w_in
    ql = mla_q(pl[..., :i_kv], g_q, w_uq, cos, sin, True)
    kl, vl = mla_kv(pl[..., i_kv:i_kr], pl[..., i_kr:i_p], g_kv, w_uk, w_uv, cos, sin, True)
    if need_ctx:
        pc = hc @ w_in
        qc = mla_q(pc[..., :i_kv], g_q, w_uq, cos, sin, False)
        kc, vc = mla_kv(pc[..., i_kv:i_kr], pc[..., i_kr:i_p], g_kv, w_uk, w_uv, cos, sin, False)
    else:
        pkv = hc @ w_in[:, i_kv:i_p]
        kc, vc = mla_kv(pkv[..., :MLA_KV_RANK], pkv[..., MLA_KV_RANK:], g_kv, w_uk, w_uv, cos, sin, False)
    al = attention(ql, jnp.concatenate([kc, kl], axis=1), jnp.concatenate([vc, vl], axis=1))
    ol = jnp.concatenate([al, multiscale_pool(pl[..., i_p:], w_pool, s_pool)], axis=-1) @ w_out
    oc = None
    if need_ctx:
        ac = attention(qc, kc, vc)
        oc = jnp.concatenate([ac, multiscale_pool(pc[..., i_p:], w_pool, s_pool)], axis=-1) @ w_out
    return oc, ol


def gqa_q(a, g_q, cos, sin, rope):
    B, T, _ = a.shape
    q = rms_norm(a.reshape(B, T, GQA_HEADS, GQA_HEAD_DIM), g_q)
    if rope:
        q = apply_rope(q, cos, sin)
    return q.reshape(B, T, GQA_KV_HEADS, GQA_GROUP, GQA_HEAD_DIM)


def gqa_kv(a, g_k, cos, sin, rope):
    B, T, _ = a.shape
    k = rms_norm(a[..., :GQA_KV_W].reshape(B, T, GQA_KV_HEADS, GQA_HEAD_DIM), g_k)
    v = a[..., GQA_KV_W:].reshape(B, T, GQA_KV_HEADS, GQA_HEAD_DIM)
    if rope:
        k = apply_rope(k, cos, sin)
    return k, v


def gqa_mixer(hc, hl, w_in, g_q, g_k, w_out, cos, sin, need_ctx):
    pl = hl @ w_in
    ql = gqa_q(pl[..., :GQA_Q_W], g_q, cos, sin, True)
    kl, vl = gqa_kv(pl[..., GQA_Q_W:], g_k, cos, sin, True)
    if need_ctx:
        pc = hc @ w_in
        qc = gqa_q(pc[..., :GQA_Q_W], g_q, cos, sin, False)
        kc, vc = gqa_kv(pc[..., GQA_Q_W:], g_k, cos, sin, False)
    else:
        kc, vc = gqa_kv(hc @ w_in[:, GQA_Q_W:], g_k, cos, sin, False)
    ol = attention(ql, jnp.concatenate([kc, kl], axis=1), jnp.concatenate([vc, vl], axis=1)) @ w_out
    oc = attention(qc, kc, vc) @ w_out if need_ctx else None
    return oc, ol


def conv_ffn(h, w_up, conv_w, conv_b, w_down):
    a = h @ w_up
    g, u = a[..., :D_FF], a[..., D_FF:]
    T = g.shape[1]
    half = CONV_W // 2
    gp = jnp.pad(g, ((0, 0), (half, half), (0, 0)))
    acc = conv_b + gp[:, 0:T] * conv_w[0]
    for j in range(1, CONV_W):
        acc = acc + gp[:, j:j + T] * conv_w[j]
    return (jax.nn.silu(acc) * u) @ w_down


def setup_inputs(seed: int = 0) -> dict:
    key = jax.random.key(seed)
    ks = iter(jax.random.split(key, 32))
    D = D_MODEL

    def normal(shape, scale=1.0):
        return jax.random.normal(next(ks), shape, jnp.float32) * scale

    def gain(shape):
        return 1.0 + 0.05 * normal(shape)

    return {
        'x': normal((BATCH, SEQ, D)),
        'c': normal((BATCH, D)),
        'ctx': normal((BATCH, CTX_LEN, D)),
        'c_ctx': normal((D,)),
        'w_mod': normal((DEPTH, D, N_MOD * D), D ** -0.5),
        'b_mod': normal((DEPTH, N_MOD * D), 0.02),
        'mix0_w_in': normal((N_EVEN, D, MIX0_IN), D ** -0.5),
        'mla_g_q': gain((N_EVEN, MLA_Q_RANK)),
        'mla_w_uq': normal((N_EVEN, MLA_Q_RANK, MLA_HEADS * (MLA_NOPE + MLA_ROPE)), MLA_Q_RANK ** -0.5),
        'mla_g_kv': gain((N_EVEN, MLA_KV_RANK)),
        'mla_w_uk': normal((N_EVEN, MLA_KV_RANK, MLA_HEADS * MLA_NOPE), MLA_KV_RANK ** -0.5),
        'mla_w_uv': normal((N_EVEN, MLA_KV_RANK, MLA_HEADS * MLA_V), MLA_KV_RANK ** -0.5),
        'pool_w': normal((N_EVEN, len(POOL_WINDOWS), POOL_GROUP, POOL_GROUP), POOL_GROUP ** -0.5),
        'pool_scale': gain((N_EVEN, POOL_WIDTH)),
        'mix0_w_out': normal((N_EVEN, MIX0_OUT, D), MIX0_OUT ** -0.5),
        'gqa_w_in': normal((N_ODD, D, GQA_Q_W + 2 * GQA_KV_W), D ** -0.5),
        'gqa_g_q': gain((N_ODD, GQA_HEAD_DIM)),
        'gqa_g_k': gain((N_ODD, GQA_HEAD_DIM)),
        'gqa_w_out': normal((N_ODD, GQA_Q_W, D), GQA_Q_W ** -0.5),
        'ffn_w_up': normal((DEPTH, D, 2 * D_FF), D ** -0.5),
        'ffn_conv_w': normal((DEPTH, CONV_W, D_FF), CONV_W ** -0.5),
        'ffn_conv_b': normal((DEPTH, D_FF), 0.02),
        'ffn_w_down': normal((DEPTH, D_FF, D), D_FF ** -0.5),
        'g_final': gain((D,)),
    }


def reference(x, c, ctx, c_ctx, w_mod, b_mod, mix0_w_in, mla_g_q, mla_w_uq, mla_g_kv, mla_w_uk, mla_w_uv,
              pool_w, pool_scale, mix0_w_out, gqa_w_in, gqa_g_q, gqa_g_k, gqa_w_out,
              ffn_w_up, ffn_conv_w, ffn_conv_b, ffn_w_down, g_final):
    B, N, D = x.shape
    cos_a, sin_a = axial_rope_tables(N, MLA_ROPE)
    cos_c, sin_c = axial_rope_tables(N, GQA_HEAD_DIM)
    xl, xc = x, ctx
    for i in range(DEPTH):
        last = i == DEPTH - 1
        j = i // 2
        ml = (jax.nn.silu(c) @ w_mod[i] + b_mod[i]).reshape(B, N_MOD, 1, D)
        mc = (jax.nn.silu(c_ctx) @ w_mod[i] + b_mod[i]).reshape(N_MOD, D)
        hl = modulate(xl, ml[:, 0], ml[:, 1])
        hc = modulate(xc, mc[0], mc[1])
        if i % 2 == 0:
            oc, ol = mla_pool_mixer(hc, hl, mix0_w_in[j], mla_g_q[j], mla_w_uq[j], mla_g_kv[j], mla_w_uk[j],
                                    mla_w_uv[j], pool_w[j], pool_scale[j], mix0_w_out[j], cos_a, sin_a, not last)
        else:
            oc, ol = gqa_mixer(hc, hl, gqa_w_in[j], gqa_g_q[j], gqa_g_k[j], gqa_w_out[j], cos_c, sin_c, not last)
        xl = xl + ml[:, 2] * ol
        xl = xl + ml[:, 5] * conv_ffn(modulate(xl, ml[:, 3], ml[:, 4]),
                                      ffn_w_up[i], ffn_conv_w[i], ffn_conv_b[i], ffn_w_down[i])
        if not last:
            xc = xc + mc[2] * oc
            xc = xc + mc[5] * conv_ffn(modulate(xc, mc[3], mc[4]),
                                       ffn_w_up[i], ffn_conv_w[i], ffn_conv_b[i], ffn_w_down[i])
    return rms_norm(xl, g_final)
```

```cpp
#include <hip/hip_runtime.h>
#include <hip/hip_cooperative_groups.h>
#include <cstdio>
#include <cstdint>
namespace cg = cooperative_groups;

#define LAS __attribute__((address_space(3)))
typedef unsigned short bf16_t;
typedef short bf16x8 __attribute__((ext_vector_type(8)));
typedef short s16x4 __attribute__((ext_vector_type(4)));
typedef float f32x4 __attribute__((ext_vector_type(4)));
typedef float f32x16 __attribute__((ext_vector_type(16)));
typedef unsigned u32x4 __attribute__((ext_vector_type(4)));
typedef unsigned u32x2 __attribute__((ext_vector_type(2)));

constexpr int DM = 1024, NB = 4, NSEQ = 8192, NCTX = 256;
constexpr int RL = NB * NSEQ;
constexpr int RT = RL + NB * NCTX;
constexpr int DFF = 2816;
constexpr int NIN0 = 1280;
constexpr float EPSN = 1e-6f;

constexpr size_t MiB = 1u << 20;
constexpr size_t WS_MOD = 0;
constexpr size_t WS_RS = 512 * 1024;
constexpr size_t WS_ROPEA = 1 * MiB;
constexpr size_t WS_ROPEC = 2 * MiB;
constexpr size_t WS_CTL = 6 * MiB;
constexpr size_t CTL_BYTES = 65536;
constexpr int CW_PANEL = 4096;
constexpr int LDS_XCH = 131072 + 256;
constexpr int LDS_BARST = 131072 + 64;
constexpr size_t WS_WIN0 = 8 * MiB;
constexpr size_t WS_WUQ = WS_WIN0 + (size_t)1280 * 1024 * 2;
constexpr size_t WS_WUKV = 11 * MiB + 256 * 1024;
constexpr size_t WS_WPOOL = WS_WUKV + 512 * 1024;
constexpr size_t WS_WOUT0 = WS_WPOOL + 512 * 1024;
constexpr size_t WS_WGIN = WS_WOUT0 + 2 * MiB;
constexpr size_t WS_WGOUT = WS_WGIN + 3 * MiB;
constexpr size_t WS_WUP = WS_WGOUT + 2 * MiB;
constexpr size_t WS_WDOWN = WS_WUP + 22 * MiB;
static_assert(WS_WDOWN + 11 * MiB <= 56 * MiB, "weights");
constexpr size_t WS_H = 56 * MiB;
constexpr size_t WS_X1 = 122 * MiB;
constexpr size_t WS_V0 = 122 * MiB;
constexpr size_t WS_DP = 155 * MiB;
constexpr size_t WS_CAT = 254 * MiB;
constexpr size_t WS_Q0 = 320 * MiB;
constexpr size_t WS_K0 = WS_Q0 + (size_t)RT * 768 * 2;
constexpr size_t WS_PL = 419 * MiB;
constexpr size_t WS_ACT = 254 * MiB;
constexpr size_t WS_HALO = 436 * MiB;
constexpr size_t WS_XSLOT = 472 * MiB;
constexpr size_t WS_SLAB = 474 * MiB;
constexpr int CW_SLAB = 14336;
constexpr size_t WS_PG = 254 * MiB;
constexpr size_t WS_CAT1 = 353 * MiB;
constexpr size_t WS_END = 512 * MiB;
constexpr size_t HSZ = (size_t)528 * DFF;
static_assert(WS_K0 + (size_t)RT * 768 * 2 <= WS_PL && WS_PL + (size_t)RT * 1280 * 2 <= WS_END, "L0 map");
static_assert(WS_ACT + (size_t)RT * DFF * 2 <= WS_HALO && WS_HALO + 6 * HSZ * 4 <= WS_END, "FFN map");

constexpr int LDS_BYTES = 147456;

struct Params {
    const float* in[24];
    float* out;
    unsigned char* ws;
};

__device__ __forceinline__ unsigned cvt_pk_bf16(float lo, float hi) { unsigned r; asm volatile("v_cvt_pk_bf16_f32 %0, %1, %2" : "=v"(r) : "v"(lo), "v"(hi)); return r; }
__device__ __forceinline__ float bf_lo(unsigned w) { return __uint_as_float(w << 16); }
__device__ __forceinline__ float bf_hi(unsigned w) { return __uint_as_float(w & 0xffff0000u); }
__device__ __forceinline__ float wave_sum(float v) {
#pragma unroll
    for (int o = 1; o < 64; o <<= 1) v += __shfl_xor(v, o);
    return v;
}
__device__ __forceinline__ float silu_f(float x) { return x * __builtin_amdgcn_rcpf(1.0f + __builtin_amdgcn_exp2f(-1.4426950408889634f * x)); }

namespace pg8 {
constexpr int BM = 256, BK = 64, HALF = 128, HTB = HALF * BK * 2, STAGE_BYTES = 8 * HTB, NXCD = 8, WGM = 8;
__host__ __device__ __forceinline__ int lds_byte(int r, int c) { const int st = (r >> 4) * 2 + (c >> 5), rr = r & 15, cc = c & 31, ob = rr * 64 + cc * 2; return st * 1024 + (ob ^ (((ob >> 9) & 1) << 5)); }
__host__ __device__ __forceinline__ void stage_rc(int b, int& R, int& C) { const int st = b / 1024, sb = b % 1024, swz = sb ^ (((sb >> 9) & 1) << 5); R = (st >> 1) * 16 + swz / 64; C = (st & 1) * 32 + (swz % 64) / 2; }
__host__ __device__ __forceinline__ int perm32(int rho) { const int n = rho >> 4, i = rho & 15; return 8 * (i >> 2) + 4 * n + (i & 3); }

struct Unit { int pm, pn, kt0, nkt, kh; };
struct Gemm { const bf16_t* A; const bf16_t* Bt; int M, N, K, lda, ldb; };

struct StaticOrder {
    int nM, nN, nwg, G, c;
    __host__ __device__ __forceinline__ void init(int M, int N, int G_, int c_) { nM = M / BM; nN = N / BM; nwg = nM * nN; G = G_; c = c_; }
    __host__ __device__ __forceinline__ bool next(int i, Unit& u) const {
        const long L = (long)i * G + c; if (L >= nwg) return false;
        int wgid = (int)L; { const int q = nwg / NXCD, r = nwg % NXCD, xcd = wgid % NXCD, off = wgid / NXCD; wgid = (xcd < r ? xcd * (q + 1) : r * (q + 1) + (xcd - r) * q) + off; }
        const int nig = WGM * nN, gid = wgid / nig, fm = gid * WGM, gsz = (nM - fm) < WGM ? (nM - fm) : WGM;
        u.pm = fm + ((wgid % nig) % gsz); u.pn = (wgid % nig) / gsz; u.kt0 = 0; u.nkt = 0; u.kh = -1; return true;
    }
};

struct AlignedOrder {
    int nM, nN, nwg, G, c, nmain, ntk;
    __host__ __device__ __forceinline__ void init(int M, int N, int G_, int c_, int ntk_ = 0) { nM = M / BM; nN = N / BM; nwg = nM * nN; G = G_; c = c_; ntk = ntk_; const int blk = NXCD * WGM * nN; nmain = (nwg / blk) * blk; }
    __host__ __device__ __forceinline__ bool next(int i, Unit& u) const {
        const long L = (long)i * G + c; const int ntail = nwg - nmain; if (L >= nmain + (ntk ? 2 : 1) * ntail) return false;
        int wgid = (int)L; u.kt0 = 0; u.nkt = 0; u.kh = -1;
        if (wgid < nmain) { const int q = nmain / NXCD; wgid = (wgid % NXCD) * q + wgid / NXCD; }
        else if (ntk) { const int j = wgid - nmain; wgid = nmain + (j >> 1); u.kh = j & 1; u.nkt = ntk >> 1; u.kt0 = u.kh * u.nkt; }
        const int nig = WGM * nN, gid = wgid / nig, fm = gid * WGM, gsz = (nM - fm) < WGM ? (nM - fm) : WGM;
        u.pm = fm + ((wgid % nig) % gsz); u.pn = (wgid % nig) / gsz; return true;
    }
};

template <class Epi, class Sched, bool ALIGN_EPI = true, bool SP2 = true>
__device__ __forceinline__ void gemm_phase(LAS unsigned char* lds, const Gemm g, const Sched& S, const Epi& E) {
    int tid = threadIdx.x; asm volatile("" : "+v"(tid));
    const int wid = __builtin_amdgcn_readfirstlane(tid >> 6), lane = tid & 63, wr = wid >> 2, wc = wid & 3, fr = lane & 15, fq = lane >> 4;
    const int K = g.K, ntK = K / BK;
    unsigned voffA[2], voffB[2];
#pragma unroll
    for (int i = 0; i < 2; ++i) { int R, C; stage_rc(tid * 16 + i * 8192, R, C); const int Rb = Epi::PERM ? ((R & ~31) + perm32(R & 31)) : R;
        voffA[i] = (unsigned)(R * g.lda + C) * 2u; voffB[i] = (unsigned)(Rb * g.ldb + C) * 2u; }
    const size_t kstep = (size_t)(BK * 2);
    const size_t hstepA = (size_t)HALF * g.lda * 2, hstepB = (size_t)HALF * g.ldb * 2;
    const size_t tstepA = 2 * hstepA, tstepB = 2 * hstepB;
    const unsigned ldsw = (unsigned)wid * 1024u;
    const int aoff = lds_byte(wr * 64 + fr, fq * 8), boff = lds_byte(wc * 32 + fr, fq * 8);
#define PG8_SA(b, h) (((b) * 2 + (h)) * HTB)
#define PG8_SB(b, h) ((4 + (b) * 2 + (h)) * HTB)
#define PG8_STAGE(bufoff, gbase, voff) do { _Pragma("unroll") for (int _i = 0; _i < 2; ++_i) \
        __builtin_amdgcn_global_load_lds((const unsigned*)((const char*)(gbase) + (voff)[_i]), (LAS unsigned*)(lds + (bufoff) + ldsw + _i * 8192), 16, 0, 0); } while (0)
#define PG8_LDA(dst, b, h) do { _Pragma("unroll") for (int m = 0; m < 4; ++m) _Pragma("unroll") for (int k = 0; k < 2; ++k) dst[m][k] = *(const LAS bf16x8*)(lds + PG8_SA(b, h) + aoff + m * 2048 + k * 1024); } while (0)
#define PG8_LDB(dst, b, h) do { _Pragma("unroll") for (int n = 0; n < 2; ++n) _Pragma("unroll") for (int k = 0; k < 2; ++k) dst[n][k] = *(const LAS bf16x8*)(lds + PG8_SB(b, h) + boff + n * 2048 + k * 1024); } while (0)
#define PG8_MMA(ai, bj, At, Bt) do { __builtin_amdgcn_s_setprio(1); _Pragma("unroll") for (int m = 0; m < 4; ++m) _Pragma("unroll") for (int n = 0; n < 2; ++n) _Pragma("unroll") for (int k = 0; k < 2; ++k) \
        acc[ai][bj][m][n] = __builtin_amdgcn_mfma_f32_16x16x32_bf16(Bt[n][k], At[m][k], acc[ai][bj][m][n], 0, 0, 0); __builtin_amdgcn_s_setprio(0); } while (0)
#define PG8_WAIT_V(n) asm volatile("s_waitcnt vmcnt(" #n ")" ::: "memory")
#define PG8_WAIT_L(n) asm volatile("s_waitcnt lgkmcnt(" #n ")" ::: "memory")
#define PG8_BAR __builtin_amdgcn_s_barrier()
#define PG8_SCHED __builtin_amdgcn_sched_barrier(0)
    Unit cur, nxt; int ui = 0;
    if (!S.next(0, cur)) return;
    int nt = cur.nkt ? cur.nkt : ntK;
    f32x4 acc[2][2][4][2];
#pragma unroll
    for (int a = 0; a < 2; ++a)
#pragma unroll
        for (int b = 0; b < 2; ++b)
#pragma unroll
            for (int m = 0; m < 4; ++m)
#pragma unroll
                for (int n = 0; n < 2; ++n) acc[a][b][m][n] = (f32x4){0.f, 0.f, 0.f, 0.f};
    bf16x8 At[4][2], B0[2][2], B1[2][2];
    const char* cA = (const char*)g.A + (size_t)cur.pm * tstepA + (size_t)cur.kt0 * kstep; const char* cB = (const char*)g.Bt + (size_t)cur.pn * tstepB + (size_t)cur.kt0 * kstep;
    if constexpr (SP2) {
        PG8_STAGE(PG8_SB(0, 0), cB, voffB); PG8_STAGE(PG8_SB(0, 1), cB + hstepB, voffB); PG8_STAGE(PG8_SA(0, 0), cA, voffA); PG8_STAGE(PG8_SA(0, 1), cA + hstepA, voffA);
        if (wr == 1) PG8_BAR;
        PG8_WAIT_V(2); PG8_BAR;
        PG8_STAGE(PG8_SB(1, 0), cB + kstep, voffB); PG8_STAGE(PG8_SA(1, 0), cA + kstep, voffA); PG8_STAGE(PG8_SB(1, 1), cB + hstepB + kstep, voffB);
        PG8_WAIT_V(6); PG8_BAR;
    }
    for (;;) {
        const bool has_next = S.next(ui + 1, nxt);
        const char* nA = has_next ? (const char*)g.A + (size_t)nxt.pm * tstepA + (size_t)nxt.kt0 * kstep : cA; const char* nB = has_next ? (const char*)g.Bt + (size_t)nxt.pn * tstepB + (size_t)nxt.kt0 * kstep : cB;
        for (int t = 0; t < nt; t += 2) {
            const bool last = (t == nt - 2);
            const char* a1 = cA + (size_t)(t + 1) * kstep;
            const char* a2 = last ? nA : cA + (size_t)(t + 2) * kstep; const char* b2 = last ? nB : cB + (size_t)(t + 2) * kstep;
            const char* a3 = a2 + kstep; const char* b3 = b2 + kstep;
            PG8_LDB(B0, 0, 0); PG8_LDB(B1, 0, 1); PG8_SCHED; PG8_LDA(At, 0, 0); PG8_STAGE(PG8_SA(1, 1), a1 + hstepA, voffA);
            PG8_WAIT_V(8); PG8_WAIT_L(0); PG8_BAR; PG8_MMA(0, 0, At, B0); PG8_MMA(0, 1, At, B1); PG8_BAR; PG8_SCHED;
            PG8_LDA(At, 0, 1); PG8_STAGE(PG8_SB(0, 0), b2, voffB); PG8_STAGE(PG8_SB(0, 1), b2 + hstepB, voffB); PG8_STAGE(PG8_SA(0, 0), a2, voffA);
            PG8_WAIT_V(8); PG8_WAIT_L(0); PG8_BAR; PG8_MMA(1, 0, At, B0); PG8_MMA(1, 1, At, B1); PG8_BAR; PG8_SCHED;
            PG8_LDB(B0, 1, 0); PG8_LDB(B1, 1, 1); PG8_SCHED; PG8_LDA(At, 1, 0); PG8_STAGE(PG8_SA(0, 1), a2 + hstepA, voffA);
            PG8_WAIT_V(8); PG8_WAIT_L(0); PG8_BAR; PG8_MMA(0, 0, At, B0); PG8_MMA(0, 1, At, B1); PG8_BAR; PG8_SCHED;
            PG8_LDA(At, 1, 1); PG8_STAGE(PG8_SB(1, 0), b3, voffB); PG8_STAGE(PG8_SB(1, 1), b3 + hstepB, voffB); PG8_STAGE(PG8_SA(1, 0), a3, voffA);
            PG8_WAIT_V(8); PG8_WAIT_L(0); PG8_BAR; PG8_MMA(1, 0, At, B0); PG8_MMA(1, 1, At, B1); PG8_BAR; PG8_SCHED;
        }
        if constexpr (ALIGN_EPI) { if (wr == 0) PG8_BAR; }
        E(acc, cur, wr, wc, fr, fq);
        if (!has_next) break;
#pragma unroll
        for (int a = 0; a < 2; ++a)
#pragma unroll
            for (int b = 0; b < 2; ++b)
#pragma unroll
                for (int m = 0; m < 4; ++m)
#pragma unroll
                    for (int n = 0; n < 2; ++n) acc[a][b][m][n] = (f32x4){0.f, 0.f, 0.f, 0.f};
        cur = nxt; cA = nA; cB = nB; ++ui; nt = cur.nkt ? cur.nkt : ntK;
        if constexpr (ALIGN_EPI) { if (wr == 1) PG8_BAR; }
    }
    PG8_WAIT_V(0);
    if constexpr (!ALIGN_EPI) { if (wr == 0) PG8_BAR; }
    PG8_BAR;
#undef PG8_SA
#undef PG8_SB
#undef PG8_STAGE
#undef PG8_LDA
#undef PG8_LDB
#undef PG8_MMA
#undef PG8_WAIT_V
#undef PG8_WAIT_L
#undef PG8_BAR
#undef PG8_SCHED
}

typedef f32x4 Acc[2][2][4][2];

struct EpiStore {
    static constexpr bool PERM = true;
    bf16_t* O; int ldc;
    __device__ __forceinline__ void operator()(Acc& acc, const Unit& u, int wr, int wc, int fr, int fq) const {
        const int row0 = u.pm * BM + wr * 64 + fr, col0 = u.pn * BM + wc * 32 + 8 * fq;
#pragma unroll
        for (int ai = 0; ai < 2; ++ai)
#pragma unroll
            for (int m = 0; m < 4; ++m) { bf16_t* rowp = O + (size_t)(row0 + ai * HALF + m * 16) * ldc + col0;
#pragma unroll
                for (int bj = 0; bj < 2; ++bj) { const f32x4 v0 = acc[ai][bj][m][0], v1 = acc[ai][bj][m][1];
                    u32x4 w; w.x = cvt_pk_bf16(v0[0], v0[1]); w.y = cvt_pk_bf16(v0[2], v0[3]); w.z = cvt_pk_bf16(v1[0], v1[1]); w.w = cvt_pk_bf16(v1[2], v1[3]);
                    *(u32x4*)(rowp + bj * HALF) = w; } }
    }
};

struct EpiQ0 {
    static constexpr bool PERM = true;
    bf16_t* Q; const float* RS;
    __device__ __forceinline__ void operator()(Acc& acc, const Unit& u, int wr, int wc, int fr, int fq) const {
        const int row0 = u.pm * BM + wr * 64 + fr, col0 = u.pn * BM + wc * 32 + 8 * fq;
#pragma unroll
        for (int ai = 0; ai < 2; ++ai)
#pragma unroll
            for (int m = 0; m < 4; ++m) { const int r = row0 + ai * HALF + m * 16; const float rq = RS[2 * r];
                bf16_t* drow = Q + (size_t)r * 768 + col0;
#pragma unroll
                for (int bj = 0; bj < 2; ++bj) {
                    const f32x4 v0 = acc[ai][bj][m][0] * rq, v1 = acc[ai][bj][m][1] * rq;
                    u32x4 w; w.x = cvt_pk_bf16(v0[0], v0[1]); w.y = cvt_pk_bf16(v0[2], v0[3]); w.z = cvt_pk_bf16(v1[0], v1[1]); w.w = cvt_pk_bf16(v1[2], v1[3]);
                    *(u32x4*)(drow + bj * HALF) = w; }
                if (m & 1) asm volatile("" ::: "memory"); }
    }
};

struct EpiKV0 {
    static constexpr bool PERM = true;
    bf16_t* Kb; bf16_t* Vb; const float* RS;
    __device__ __forceinline__ void operator()(Acc& acc, const Unit& u, int wr, int wc, int fr, int fq) const {
        const int row0 = u.pm * BM + wr * 64 + fr, col0 = u.pn * BM + wc * 32 + 8 * fq;
        const bool isK = (u.pn * BM) < 512;
        const int ld = isK ? 768 : 512;
        const int c1 = col0 + HALF;
        const int oA = isK ? ((col0 >> 6) * 96 + (col0 & 63)) : (col0 - 512);
        const int oB = isK ? ((c1 >> 6) * 96 + (c1 & 63)) : (c1 - 512);
        bf16_t* base = isK ? Kb : Vb;
        const float* rsp = RS + 2 * row0 + 1;
#pragma unroll
        for (int ai = 0; ai < 2; ++ai) {
            float rkv[4];
#pragma unroll
            for (int m = 0; m < 4; ++m) rkv[m] = rsp[2 * (ai * HALF + m * 16)];
#pragma unroll
            for (int m = 0; m < 4; ++m) { const int r = row0 + ai * HALF + m * 16; const float rk = rkv[m];
                bf16_t* drow = base + (size_t)r * ld;
#pragma unroll
                for (int bj = 0; bj < 2; ++bj) {
                    const f32x4 v0 = acc[ai][bj][m][0] * rk, v1 = acc[ai][bj][m][1] * rk;
                    u32x4 w; w.x = cvt_pk_bf16(v0[0], v0[1]); w.y = cvt_pk_bf16(v0[2], v0[3]); w.z = cvt_pk_bf16(v1[0], v1[1]); w.w = cvt_pk_bf16(v1[2], v1[3]);
                    *(u32x4*)(drow + (bj ? oB : oA)) = w; }
                asm volatile("" ::: "memory"); } }
    }
};

struct EpiResid {
    static constexpr bool PERM = false;
    const float* xin_lat; const float* xin_ctx; float* out; const float* mod; int gj;
    __device__ __forceinline__ void operator()(Acc& acc, const Unit& u, int wr, int wc, int fr, int fq) const {
        const int rb = u.pm * BM, row0 = rb + wr * 64 + fr, col0 = u.pn * BM + wc * 32 + 4 * fq;
        const int v = rb < RL ? (rb >> 13) : 4;
        const float* gate = mod + (size_t)(v * 6 + gj) * DM;
        const float* src = rb < RL ? xin_lat + (size_t)row0 * DM : xin_ctx + (size_t)(row0 - RL) * DM;
        float* dst = out + (size_t)row0 * DM;
        f32x4 gv[2][2];
#pragma unroll
        for (int bj = 0; bj < 2; ++bj)
#pragma unroll
            for (int n = 0; n < 2; ++n) gv[bj][n] = *(const f32x4*)(gate + col0 + bj * HALF + n * 16);
#pragma unroll
        for (int ai = 0; ai < 2; ++ai)
#pragma unroll
            for (int m = 0; m < 4; ++m) { const size_t ro = (size_t)(ai * HALF + m * 16) * DM;
#pragma unroll
                for (int bj = 0; bj < 2; ++bj)
#pragma unroll
                    for (int n = 0; n < 2; ++n) { const int off = col0 + bj * HALF + n * 16;
                        const f32x4 xs = *(const f32x4*)(src + ro + off);
                        *(f32x4*)(dst + ro + off) = xs + gv[bj][n] * acc[ai][bj][m][n]; }
                asm volatile("" ::: "memory"); }
    }
};

struct EpiResidMod {
    static constexpr bool PERM = false;
    const float* xin_lat; const float* xin_ctx; const bf16_t* xsrc16; bf16_t* xout16; const float* mod; int gj;
    const float* modn; int sj; bf16_t* H; const float* gfin; float* fout;
    unsigned* xbuf; unsigned* cnt; unsigned want; LAS unsigned char* l; float* slab; unsigned* scnt; unsigned swant;
    __device__ __forceinline__ void operator()(Acc& acc, const Unit& u, int wr, int wc, int fr, int fq) const {
        const int rb = u.pm * BM, row0 = rb + wr * 64 + fr, col0 = u.pn * BM + wc * 32 + 4 * fq;
        const int v = rb < RL ? (rb >> 13) : 4;
        const int wid = wr * 4 + wc, lane = fq * 16 + fr;
        if (u.kh >= 0) {
            const int sidx = (u.pm - RL / BM) * 4 + u.pn;
            f32x4* sl = (f32x4*)(slab + (size_t)sidx * 65536) + (wid * 64 + lane);
            if (u.kh == 1) {
#pragma unroll
                for (int ai = 0; ai < 2; ++ai)
#pragma unroll
                    for (int bj = 0; bj < 2; ++bj)
#pragma unroll
                        for (int m = 0; m < 4; ++m)
#pragma unroll
                            for (int n = 0; n < 2; ++n) { *sl = acc[ai][bj][m][n]; sl += 512; asm volatile("" : "+v"(sl) :: "memory"); }
                asm volatile("s_waitcnt vmcnt(0)" ::: "memory"); __builtin_amdgcn_s_barrier(); asm volatile("" ::: "memory");
                if (wid == 0 && lane == 0) { __builtin_amdgcn_fence(__ATOMIC_RELEASE, "agent"); asm volatile("s_waitcnt vmcnt(0)" ::: "memory");
                    __hip_atomic_fetch_add(scnt + 64 * sidx, 1u, __ATOMIC_RELAXED, __HIP_MEMORY_SCOPE_AGENT); }
                return;
            }
            if (wid == 0) { unsigned sp = 0u;
                while ((unsigned)__builtin_amdgcn_readfirstlane(__hip_atomic_load(scnt + 64 * sidx, __ATOMIC_RELAXED, __HIP_MEMORY_SCOPE_AGENT)) < swant) { __builtin_amdgcn_s_sleep(2); if (++sp > (1u << 22)) break; } }
            asm volatile("s_waitcnt vmcnt(0) lgkmcnt(0)" ::: "memory"); __builtin_amdgcn_s_barrier(); asm volatile("" ::: "memory");
            __builtin_amdgcn_fence(__ATOMIC_ACQUIRE, "agent");
        }
        const bool addp = (u.kh == 0);
        const f32x4* slp = (const f32x4*)(slab + (size_t)((u.pm - RL / BM) * 4 + u.pn) * 65536) + (wid * 64 + lane);
        LAS float* P = (LAS float*)l; LAS float* S = (LAS float*)(l + 4096);
        {
            const float* gate = mod + (size_t)(v * 6 + gj) * DM;
            const float* src = rb < RL ? xin_lat + (size_t)row0 * DM : xin_ctx + (size_t)(row0 - RL) * DM;
            const bf16_t* s16 = xsrc16 + (size_t)row0 * DM;
            f32x4 gv[2][2];
#pragma unroll
            for (int bj = 0; bj < 2; ++bj)
#pragma unroll
                for (int n = 0; n < 2; ++n) gv[bj][n] = *(const f32x4*)(gate + col0 + bj * HALF + n * 16);
#pragma unroll
            for (int ai = 0; ai < 2; ++ai)
#pragma unroll
                for (int m = 0; m < 4; ++m) { const size_t ro = (size_t)(ai * HALF + m * 16) * DM; float sq = 0.f;
#pragma unroll
                    for (int bj = 0; bj < 2; ++bj)
#pragma unroll
                        for (int n = 0; n < 2; ++n) { const int off = col0 + bj * HALF + n * 16;
                            f32x4 av = acc[ai][bj][m][n]; if (addp) av += slp[(size_t)(((ai * 2 + bj) * 4 + m) * 2 + n) * 512];
                            f32x4 xs;
                            if (xsrc16) { const u32x2 w2 = *(const u32x2*)(s16 + ro + off); xs[0] = bf_lo(w2.x); xs[1] = bf_hi(w2.x); xs[2] = bf_lo(w2.y); xs[3] = bf_hi(w2.y); }
                            else xs = *(const f32x4*)(src + ro + off);
                            const f32x4 o = xs + gv[bj][n] * av;
                            acc[ai][bj][m][n] = o; sq += (o[0] * o[0] + o[1] * o[1]) + (o[2] * o[2] + o[3] * o[3]);
                            if (xout16) { u32x2 wo; wo.x = cvt_pk_bf16(o[0], o[1]); wo.y = cvt_pk_bf16(o[2], o[3]); *(u32x2*)(xout16 + (size_t)row0 * DM + ro + off) = wo; } }
                    sq += __shfl_xor(sq, 16); sq += __shfl_xor(sq, 32);
                    if (fq == 0) P[(ai * HALF + wr * 64 + m * 16 + fr) * 4 + wc] = sq;
                    asm volatile("" ::: "memory"); }
        }
        asm volatile("s_waitcnt lgkmcnt(0)" ::: "memory"); __builtin_amdgcn_s_barrier(); asm volatile("" ::: "memory");
        const int prow = wid * 32 + (lane & 31);
        if (lane < 32) { const f32x4 p4 = *(const LAS f32x4*)(P + prow * 4); const float t = (p4[0] + p4[1]) + (p4[2] + p4[3]);
            __hip_atomic_store(xbuf + (size_t)(rb + prow) * 4 + u.pn, __float_as_uint(t), __ATOMIC_RELAXED, __HIP_MEMORY_SCOPE_AGENT); }
        asm volatile("s_waitcnt vmcnt(0)" ::: "memory");
        if (lane == 0) __hip_atomic_fetch_add(cnt + 64 * u.pm, 1u, __ATOMIC_RELAXED, __HIP_MEMORY_SCOPE_AGENT);
        if (wid == 0) {
            unsigned sp = 0u;
            while ((unsigned)__builtin_amdgcn_readfirstlane(__hip_atomic_load(cnt + 64 * u.pm, __ATOMIC_RELAXED, __HIP_MEMORY_SCOPE_AGENT)) < want) {
                __builtin_amdgcn_s_sleep(2); if (++sp > (1u << 22)) break; }
            __builtin_amdgcn_fence(__ATOMIC_ACQUIRE, "agent");
        }
        asm volatile("s_waitcnt vmcnt(0) lgkmcnt(0)" ::: "memory"); __builtin_amdgcn_s_barrier(); asm volatile("" ::: "memory");
        if (lane < 32) { const unsigned* sl = xbuf + (size_t)(rb + prow) * 4; float t = 0.f;
#pragma unroll
            for (int c = 0; c < 4; ++c) t += __uint_as_float(__hip_atomic_load(sl + c, __ATOMIC_RELAXED, __HIP_MEMORY_SCOPE_AGENT));
            S[prow] = rsqrtf(t * (1.f / DM) + EPSN); }
        asm volatile("s_waitcnt lgkmcnt(0)" ::: "memory"); __builtin_amdgcn_s_barrier(); asm volatile("" ::: "memory");
        if (gfin) {
            f32x4 gf[2][2];
#pragma unroll
            for (int bj = 0; bj < 2; ++bj)
#pragma unroll
                for (int n = 0; n < 2; ++n) gf[bj][n] = *(const f32x4*)(gfin + col0 + bj * HALF + n * 16);
#pragma unroll
            for (int ai = 0; ai < 2; ++ai)
#pragma unroll
                for (int m = 0; m < 4; ++m) { const int rr = ai * HALF + wr * 64 + m * 16 + fr; const float rs = S[rr]; float* orow = fout + (size_t)(rb + rr) * DM + col0;
#pragma unroll
                    for (int bj = 0; bj < 2; ++bj)
#pragma unroll
                        for (int n = 0; n < 2; ++n) *(f32x4*)(orow + bj * HALF + n * 16) = acc[ai][bj][m][n] * rs * gf[bj][n]; }
        } else {
            const float* shp = modn + (size_t)(v * 6 + sj) * DM; const float* scp = shp + DM;
            f32x4 sh[2][2], sc[2][2];
#pragma unroll
            for (int bj = 0; bj < 2; ++bj)
#pragma unroll
                for (int n = 0; n < 2; ++n) { sh[bj][n] = *(const f32x4*)(shp + col0 + bj * HALF + n * 16); sc[bj][n] = *(const f32x4*)(scp + col0 + bj * HALF + n * 16) + 1.0f; }
#pragma unroll
            for (int ai = 0; ai < 2; ++ai)
#pragma unroll
                for (int m = 0; m < 4; ++m) { const int rr = ai * HALF + wr * 64 + m * 16 + fr; const float rs = S[rr]; bf16_t* hrow = H + (size_t)(rb + rr) * DM + col0;
#pragma unroll
                    for (int bj = 0; bj < 2; ++bj)
#pragma unroll
                        for (int n = 0; n < 2; ++n) { const f32x4 y = acc[ai][bj][m][n] * rs * sc[bj][n] + sh[bj][n];
                            u32x2 w; w.x = cvt_pk_bf16(y[0], y[1]); w.y = cvt_pk_bf16(y[2], y[3]); *(u32x2*)(hrow + bj * HALF + n * 16) = w; } }
        }
    }
};

struct EpiQKNorm {
    static constexpr bool PERM = true;
    bf16_t* O; const float* gq; const float* gk; const float2* ropec; LAS unsigned char* l;
    __device__ __forceinline__ void operator()(Acc& acc, const Unit& u, int wr, int wc, int fr, int fq) const {
        const int rb = u.pm * BM, row0 = rb + wr * 64 + fr, col0 = u.pn * BM + wc * 32 + 8 * fq;
        if (u.pn < 5) {
            const int wid = wr * 4 + wc, lane = fq * 16 + fr; const bool lat = rb < RL;
            LAS float* P = (LAS float*)l; LAS float* S = (LAS float*)(l + 8192);
#pragma unroll
            for (int ai = 0; ai < 2; ++ai)
#pragma unroll
                for (int m = 0; m < 4; ++m)
#pragma unroll
                    for (int bj = 0; bj < 2; ++bj) { const f32x4 a = acc[ai][bj][m][0], b = acc[ai][bj][m][1];
                        float sq = ((a[0] * a[0] + a[1] * a[1]) + (a[2] * a[2] + a[3] * a[3])) + ((b[0] * b[0] + b[1] * b[1]) + (b[2] * b[2] + b[3] * b[3]));
                        sq += __shfl_xor(sq, 16); sq += __shfl_xor(sq, 32);
                        if (fq == 0) P[((ai * HALF + wr * 64 + m * 16 + fr) * 2 + bj) * 4 + wc] = sq; }
            asm volatile("s_waitcnt lgkmcnt(0)" ::: "memory"); __builtin_amdgcn_s_barrier(); asm volatile("" ::: "memory");
            { const int t = wid * 64 + lane; const f32x4 p4 = *(const LAS f32x4*)(P + t * 4); S[t] = rsqrtf(((p4[0] + p4[1]) + (p4[2] + p4[3])) * (1.f / 128.f) + EPSN); }
            asm volatile("s_waitcnt lgkmcnt(0)" ::: "memory"); __builtin_amdgcn_s_barrier(); asm volatile("" ::: "memory");
            const float* gg = (u.pn < 4 ? gq : gk) + wc * 32 + 8 * fq;
            const f32x4 g0 = *(const f32x4*)gg, g1 = *(const f32x4*)(gg + 4);
#pragma unroll
            for (int ai = 0; ai < 2; ++ai) {
                f32x4 c0v[4], c1v[4];
#pragma unroll
                for (int m = 0; m < 4; ++m) { c0v[m] = (f32x4){1.f, 0.f, 1.f, 0.f}; c1v[m] = c0v[m];
                    if (lat) { const f32x4* cp = (const f32x4*)(ropec + (size_t)((rb + ai * HALF + wr * 64 + m * 16 + fr) & (NSEQ - 1)) * 64 + wc * 16 + 4 * fq); c0v[m] = cp[0]; c1v[m] = cp[1]; } }
#pragma unroll
                for (int m = 0; m < 4; ++m) { const int rr = ai * HALF + wr * 64 + m * 16 + fr, r = rb + rr;
                    const f32x4 c0 = c0v[m], c1 = c1v[m];
                    bf16_t* orow = O + (size_t)r * 1536 + col0;
#pragma unroll
                    for (int bj = 0; bj < 2; ++bj) { const float rn = S[rr * 2 + bj];
                        const f32x4 y0 = acc[ai][bj][m][0] * rn * g0, y1 = acc[ai][bj][m][1] * rn * g1;
                        u32x4 w;
                        w.x = cvt_pk_bf16(y0[0] * c0[0] - y0[1] * c0[1], y0[0] * c0[1] + y0[1] * c0[0]);
                        w.y = cvt_pk_bf16(y0[2] * c0[2] - y0[3] * c0[3], y0[2] * c0[3] + y0[3] * c0[2]);
                        w.z = cvt_pk_bf16(y1[0] * c1[0] - y1[1] * c1[1], y1[0] * c1[1] + y1[1] * c1[0]);
                        w.w = cvt_pk_bf16(y1[2] * c1[2] - y1[3] * c1[3], y1[2] * c1[3] + y1[3] * c1[2]);
                        *(u32x4*)(orow + bj * HALF) = w; }
                    asm volatile("" ::: "memory"); } }
        } else {
#pragma unroll
            for (int ai = 0; ai < 2; ++ai)
#pragma unroll
                for (int m = 0; m < 4; ++m) { bf16_t* rowp = O + (size_t)(row0 + ai * HALF + m * 16) * 1536 + col0;
#pragma unroll
                    for (int bj = 0; bj < 2; ++bj) { const f32x4 v0 = acc[ai][bj][m][0], v1 = acc[ai][bj][m][1];
                        u32x4 w; w.x = cvt_pk_bf16(v0[0], v0[1]); w.y = cvt_pk_bf16(v0[2], v0[3]); w.z = cvt_pk_bf16(v1[0], v1[1]); w.w = cvt_pk_bf16(v1[2], v1[3]);
                        *(u32x4*)(rowp + bj * HALF) = w; } }
        }
    }
};

template <int CTRL> __device__ __forceinline__ float dpp0(float v) { return __builtin_bit_cast(float, __builtin_amdgcn_update_dpp(0, __builtin_bit_cast(int, v), CTRL, 0xf, 0xf, true)); }
struct EpiFFN {
    static constexpr bool PERM = true;
    bf16_t* ACT; float* HALO; const float* cw; const float* cb;
    __device__ __forceinline__ void operator()(Acc& acc, const Unit& u, int wr, int wc, int fr, int fq) const {
        const int ch0 = u.pn * 128 + wc * 32 + 8 * fq;
        const bool e0 = (fr == 0), e15 = (fr == 15);
#pragma unroll
        for (int n = 0; n < 2; ++n) {
            const int ch = ch0 + 4 * n;
            const f32x4 w0 = *(const f32x4*)(cw + ch), w1 = *(const f32x4*)(cw + DFF + ch), w2 = *(const f32x4*)(cw + 2 * DFF + ch), bb = *(const f32x4*)(cb + ch);
#pragma unroll
            for (int ai = 0; ai < 2; ++ai) {
                const int q = 4 * u.pm + 2 * ai + wr;
                float* hp0 = HALO + (size_t)q * DFF + ch;
                if (e0) { *(f32x4*)(hp0 + HSZ) = acc[ai][0][0][n]; *(f32x4*)(hp0 + 2 * HSZ) = acc[ai][1][0][n]; }
                if (e15) { *(f32x4*)(hp0 + 4 * HSZ) = acc[ai][0][3][n]; *(f32x4*)(hp0 + 5 * HSZ) = acc[ai][1][3][n]; }
                f32x4 pre[4];
#pragma unroll
                for (int m = 0; m < 4; ++m) {
#pragma unroll
                    for (int e = 0; e < 4; ++e) {
                        const float g = acc[ai][0][m][n][e];
                        float pv;
                        if (m == 0)
                            asm volatile("v_mov_b32 %0, %1\n\tv_fmac_f32_dpp %0, %2, %3 row_shr:1 row_mask:0xf bank_mask:0xf bound_ctrl:1\n\tv_fmac_f32 %0, %2, %4\n\t"
                                         "v_fmac_f32_dpp %0, %2, %5 row_shl:1 row_mask:0xf bank_mask:0xf bound_ctrl:1\n\tv_fmac_f32_dpp %0, %6, %5 row_shr:15 row_mask:0xf bank_mask:0xf bound_ctrl:1"
                                         : "=&v"(pv) : "v"(bb[e]), "v"(g), "v"(w0[e]), "v"(w1[e]), "v"(w2[e]), "v"(acc[ai][0][1][n][e]));
                        else if (m == 3)
                            asm volatile("v_mov_b32 %0, %1\n\tv_fmac_f32_dpp %0, %2, %3 row_shr:1 row_mask:0xf bank_mask:0xf bound_ctrl:1\n\tv_fmac_f32 %0, %2, %4\n\t"
                                         "v_fmac_f32_dpp %0, %2, %5 row_shl:1 row_mask:0xf bank_mask:0xf bound_ctrl:1\n\tv_fmac_f32_dpp %0, %6, %3 row_shl:15 row_mask:0xf bank_mask:0xf bound_ctrl:1"
                                         : "=&v"(pv) : "v"(bb[e]), "v"(g), "v"(w0[e]), "v"(w1[e]), "v"(w2[e]), "v"(acc[ai][0][2][n][e]));
                        else
                            asm volatile("v_mov_b32 %0, %1\n\tv_fmac_f32_dpp %0, %2, %3 row_shr:1 row_mask:0xf bank_mask:0xf bound_ctrl:1\n\tv_fmac_f32 %0, %2, %4\n\t"
                                         "v_fmac_f32_dpp %0, %2, %5 row_shl:1 row_mask:0xf bank_mask:0xf bound_ctrl:1\n\tv_fmac_f32_dpp %0, %6, %3 row_shl:15 row_mask:0xf bank_mask:0xf bound_ctrl:1\n\t"
                                         "v_fmac_f32_dpp %0, %7, %5 row_shr:15 row_mask:0xf bank_mask:0xf bound_ctrl:1"
                                         : "=&v"(pv) : "v"(bb[e]), "v"(g), "v"(w0[e]), "v"(w1[e]), "v"(w2[e]), "v"(acc[ai][0][m - 1][n][e]), "v"(acc[ai][0][m + 1][n][e]));
                        pre[m][e] = pv;
                    }
                }
                if (e0) *(f32x4*)(hp0) = pre[0];
                if (e15) *(f32x4*)(hp0 + 3 * HSZ) = pre[3];
#pragma unroll
                for (int m = 0; m < 4; ++m)
#pragma unroll
                    for (int e = 0; e < 4; ++e) acc[ai][0][m][n][e] = silu_f(pre[m][e]) * acc[ai][1][m][n][e];
                __builtin_amdgcn_sched_barrier(0);
            }
        }
#pragma unroll
        for (int ai = 0; ai < 2; ++ai)
#pragma unroll
            for (int m = 0; m < 4; ++m) { const int r = u.pm * BM + ai * HALF + wr * 64 + m * 16 + fr; const f32x4 v0 = acc[ai][0][m][0], v1 = acc[ai][0][m][1];
                u32x4 w; w.x = cvt_pk_bf16(v0[0], v0[1]); w.y = cvt_pk_bf16(v0[2], v0[3]); w.z = cvt_pk_bf16(v1[0], v1[1]); w.w = cvt_pk_bf16(v1[2], v1[3]);
                *(u32x4*)(ACT + (size_t)r * DFF + ch0) = w; }
    }
};
}

namespace att {
constexpr int NW = 8, QBLK = 32, KVBLK = 64;
constexpr size_t SHM_V = KVBLK * 128 * 2, SHM_K = KVBLK * 128 * 2, SHM_ATTN = 2 * SHM_V + 2 * SHM_K + NW * 64 * 4;
#define KSWZ(row, colB) ((row) * 256 + ((colB) ^ (((row) & 7) << 4)))
#define SBAR() __builtin_amdgcn_sched_barrier(0)
__device__ __forceinline__ int crow(int r, int hi) { return (r & 3) + 8 * (r >> 2) + 4 * hi; }
__device__ __forceinline__ unsigned cvtpk(float lo, float hi) { unsigned r; asm volatile("v_cvt_pk_bf16_f32 %0, %1, %2" : "=v"(r) : "v"(lo), "v"(hi)); return r; }

__device__ __forceinline__ void partialSM(f32x16& p0, f32x16& p1, float& m_reg, float& mn, float& alpha, const float C, const float thr_raw) {
    float pmax = p0[0];
#pragma unroll
    for (int r = 1; r < 16; ++r) pmax = fmaxf(pmax, p0[r]);
#pragma unroll
    for (int r = 0; r < 16; ++r) pmax = fmaxf(pmax, p1[r]);
    { auto rr = __builtin_amdgcn_permlane32_swap(__float_as_uint(pmax), __float_as_uint(pmax), false, false);
      pmax = fmaxf(__uint_as_float(rr[0]), __uint_as_float(rr[1])); }
    if (__builtin_expect(__all(pmax - m_reg <= thr_raw), 1)) { mn = m_reg; alpha = 1.f; }
    else { mn = fmaxf(m_reg, pmax); alpha = __builtin_amdgcn_exp2f((m_reg - mn) * C); m_reg = mn; }
    const float mnC = -mn * C;
#pragma unroll
    for (int r = 0; r < 16; ++r) p0[r] = fmaf(p0[r], C, mnC);
#pragma unroll
    for (int r = 0; r < 16; ++r) p1[r] = fmaf(p1[r], C, mnC);
#pragma unroll
    for (int r = 0; r < 16; ++r) p0[r] = __builtin_amdgcn_exp2f(p0[r]);
}
__device__ __forceinline__ void finishSM(f32x16& p0, f32x16& p1, float alpha, float& l_reg, bf16x8& pa0, bf16x8& pa1, bf16x8& pa2, bf16x8& pa3) {
#pragma unroll
    for (int r = 0; r < 16; ++r) p1[r] = __builtin_amdgcn_exp2f(p1[r]);
    float ps = 0;
#pragma unroll
    for (int r = 0; r < 16; ++r) ps += p0[r];
#pragma unroll
    for (int r = 0; r < 16; ++r) ps += p1[r];
    { auto rr = __builtin_amdgcn_permlane32_swap(__float_as_uint(ps), __float_as_uint(ps), false, false);
      ps = __uint_as_float(rr[0]) + __uint_as_float(rr[1]); }
    l_reg = l_reg * alpha + ps;
#define PK4(P, BASE, OUT) do { unsigned a0 = cvtpk(P[BASE + 0], P[BASE + 1]), a1 = cvtpk(P[BASE + 2], P[BASE + 3]);   \
    unsigned b0 = cvtpk(P[BASE + 4], P[BASE + 5]), b1 = cvtpk(P[BASE + 6], P[BASE + 7]);                              \
    auto r0 = __builtin_amdgcn_permlane32_swap(a0, b0, false, false); auto r1 = __builtin_amdgcn_permlane32_swap(a1, b1, false, false); \
    u32x4 w = {r0[0], r1[0], r0[1], r1[1]}; OUT = *reinterpret_cast<bf16x8*>(&w); } while (0)
    PK4(p0, 0, pa0); PK4(p0, 8, pa1); PK4(p1, 0, pa2); PK4(p1, 8, pa3);
#undef PK4
}
template <int NDQ>
__device__ __forceinline__ void qkt(f32x16& p0, f32x16& p1, const char* Ks, const bf16x8* qr, int r32, int hi) {
    p0 = f32x16{}; p1 = f32x16{};
#pragma unroll
    for (int d0 = 0; d0 < NDQ; ++d0) { const int cb = (d0 * 16 + hi * 8) * 2;
        const bf16x8 b0 = *reinterpret_cast<const bf16x8*>(Ks + KSWZ(r32, cb));
        const bf16x8 b1 = *reinterpret_cast<const bf16x8*>(Ks + KSWZ(32 + r32, cb));
        p0 = __builtin_amdgcn_mfma_f32_32x32x16_bf16(b0, qr[d0], p0, 0, 0, 0);
        p1 = __builtin_amdgcn_mfma_f32_32x32x16_bf16(b1, qr[d0], p1, 0, 0, 0); }
}
__device__ __forceinline__ int v_st(int k, int c) { const int kk = (k & ~0xC) | ((k & 4) << 1) | ((k & 8) >> 1); return ((kk >> 3) * 4 + (c >> 5)) * 512 + ((kk & 7) * 32 + (c & 31)) * 2; }
__device__ __forceinline__ int v_rd_base(int lane) { return ((lane & 3) << 3) | (((lane >> 2) & 3) << 6) | (((lane >> 4) & 1) << 5) | (((lane >> 5) & 1) << 8); }
constexpr int v_rd_off(int d0, int ks, int half) { return d0 * 512 + ks * 4096 + half * 2048; }
template <int OFF> __device__ __forceinline__ s16x4 tr_read(int vb) {
    s16x4 r; asm volatile("ds_read_b64_tr_b16 %0, %1 offset:%2" : "=&v"(r) : "v"(vb), "i"(OFF) : "memory"); return r;
}
template <int D0> __device__ __forceinline__ void pv_one(f32x16& od, int vb, bf16x8 pa0, bf16x8 pa1, bf16x8 pa2, bf16x8 pa3) {
    const s16x4 l0 = tr_read<v_rd_off(D0, 0, 0)>(vb), h0 = tr_read<v_rd_off(D0, 0, 1)>(vb), l1 = tr_read<v_rd_off(D0, 1, 0)>(vb), h1 = tr_read<v_rd_off(D0, 1, 1)>(vb);
    const s16x4 l2 = tr_read<v_rd_off(D0, 2, 0)>(vb), h2 = tr_read<v_rd_off(D0, 2, 1)>(vb), l3 = tr_read<v_rd_off(D0, 3, 0)>(vb), h3 = tr_read<v_rd_off(D0, 3, 1)>(vb);
    asm volatile("s_waitcnt lgkmcnt(0)" ::: "memory"); SBAR();
#define PK(L, H) (bf16x8){L[0], L[1], L[2], L[3], H[0], H[1], H[2], H[3]}
    od = __builtin_amdgcn_mfma_f32_32x32x16_bf16(pa0, PK(l0, h0), od, 0, 0, 0);
    od = __builtin_amdgcn_mfma_f32_32x32x16_bf16(pa1, PK(l1, h1), od, 0, 0, 0);
    od = __builtin_amdgcn_mfma_f32_32x32x16_bf16(pa2, PK(l2, h2), od, 0, 0, 0);
    od = __builtin_amdgcn_mfma_f32_32x32x16_bf16(pa3, PK(l3, h3), od, 0, 0, 0);
#undef PK
}
template <int NDV> __device__ __forceinline__ void pv_d0(f32x16* o, int vb, bf16x8 pa0, bf16x8 pa1, bf16x8 pa2, bf16x8 pa3) {
    pv_one<0>(o[0], vb, pa0, pa1, pa2, pa3); pv_one<1>(o[1], vb, pa0, pa1, pa2, pa3);
    if constexpr (NDV == 4) { pv_one<2>(o[2], vb, pa0, pa1, pa2, pa3); pv_one<3>(o[3], vb, pa0, pa1, pa2, pa3); }
}

template <int NDQ, int NDV>
__device__ __forceinline__ void attn_unit(const bf16_t* __restrict__ Qb, const int ldq,
                                          const bf16_t* __restrict__ Kc, const bf16_t* __restrict__ Kl, const int ldk,
                                          const bf16_t* __restrict__ Vc, const bf16_t* __restrict__ Vl, const int ldv,
                                          bf16_t* __restrict__ Ob, const int ldo, const int nkeys, const int nctx,
                                          const float C, const float thr_raw, char* lds, const float2* ropeq = nullptr, const int tq0 = 0) {
    constexpr int SDEPTH = 2;
    constexpr int WK = NDQ * 16, WV = NDV * 32;
    int tid = threadIdx.x; asm volatile("" : "+v"(tid));
    const int wid = tid >> 6, lane = tid & 63, r32 = lane & 31, hi = lane >> 5;
    char* V_lds = lds; char* K_lds = lds + 2 * SHM_V;
    float* ws = (float*)(lds + 2 * SHM_V + 2 * SHM_K) + wid * 64; float* li_l = ws; float* al_l = ws + 32;
    float m_reg = -1e30f, l_reg = 0; f32x16 o[NDV] = {}; bf16x8 qr[NDQ];
    const bf16_t* Qw = Qb + (long)(wid * QBLK + r32) * ldq + hi * 8;
#pragma unroll
    for (int d0 = 0; d0 < NDQ; ++d0) qr[d0] = *reinterpret_cast<const bf16x8*>(Qw + d0 * 16);
    if constexpr (NDQ == 6) {
        if (ropeq) {
            const f32x4* cp = (const f32x4*)(ropeq + (size_t)(tq0 + wid * QBLK + r32) * 16 + hi * 4);
#pragma unroll
            for (int dd = 0; dd < 2; ++dd) { const f32x4 c0 = cp[dd * 4], c1 = cp[dd * 4 + 1]; const bf16x8 q = qr[4 + dd];
                float x[8];
#pragma unroll
                for (int j = 0; j < 8; ++j) x[j] = __uint_as_float(((unsigned)(unsigned short)q[j]) << 16);
                u32x4 w;
                w.x = cvtpk(x[0] * c0[0] - x[1] * c0[1], x[0] * c0[1] + x[1] * c0[0]);
                w.y = cvtpk(x[2] * c0[2] - x[3] * c0[3], x[2] * c0[3] + x[3] * c0[2]);
                w.z = cvtpk(x[4] * c1[0] - x[5] * c1[1], x[4] * c1[1] + x[5] * c1[0]);
                w.w = cvtpk(x[6] * c1[2] - x[7] * c1[3], x[6] * c1[3] + x[7] * c1[2]);
                qr[4 + dd] = *reinterpret_cast<bf16x8*>(&w); }
        }
    }
    const int sr = tid >> 4, sc = (tid & 15) * 8, vst0 = v_st(sr, sc), vst1 = v_st(32 + sr, sc);
    const int scK = sc < WK ? sc : sc - (128 - WK), scV = sc < WV ? sc : sc - (128 - WV);
    const int vb0 = (int)(uintptr_t)V_lds + v_rd_base(lane);
    struct { bf16x8 vs0, vs1, ks0, ks1; } sr_[SDEPTH];
    constexpr bool MLA = (NDQ == 6 && NDV == 2);
    const int mvr = tid >> 3, mvc = (tid & 7) * 8, mk0r = tid / 12, mk0c = (tid - mk0r * 12) * 8, mk1r = (tid + 512) / 12, mk1c = ((tid + 512) - mk1r * 12) * 8;
    const int mvst = v_st(mvr, mvc); const bool mk1 = tid < 256;
#define SLOAD(i, k0) do { const int k0_ = (k0); const bf16_t* kp_ = k0_ < nctx ? Kc + (long)k0_ * ldk : Kl + (long)(k0_ - nctx) * ldk; \
    const bf16_t* vp_ = k0_ < nctx ? Vc + (long)k0_ * ldv : Vl + (long)(k0_ - nctx) * ldv; \
    if constexpr (MLA) { \
      sr_[i].vs0 = *reinterpret_cast<const bf16x8*>(vp_ + (long)mvr * ldv + mvc); \
      sr_[i].ks0 = *reinterpret_cast<const bf16x8*>(kp_ + (long)mk0r * ldk + mk0c); \
      if (mk1) sr_[i].ks1 = *reinterpret_cast<const bf16x8*>(kp_ + (long)mk1r * ldk + mk1c); \
    } else { \
    sr_[i].vs0 = *reinterpret_cast<const bf16x8*>(vp_ + (long)sr * ldv + scV); sr_[i].vs1 = *reinterpret_cast<const bf16x8*>(vp_ + (long)(32 + sr) * ldv + scV); \
    sr_[i].ks0 = *reinterpret_cast<const bf16x8*>(kp_ + (long)sr * ldk + scK); sr_[i].ks1 = *reinterpret_cast<const bf16x8*>(kp_ + (long)(32 + sr) * ldk + scK); } } while (0)
#define SWRITE(b, i) do { if constexpr (MLA) { \
    *(bf16x8*)(V_lds + (b) * SHM_V + mvst) = sr_[i].vs0; \
    *(bf16x8*)(K_lds + (b) * SHM_K + KSWZ(mk0r, mk0c * 2)) = sr_[i].ks0; \
    if (mk1) *(bf16x8*)(K_lds + (b) * SHM_K + KSWZ(mk1r, mk1c * 2)) = sr_[i].ks1; \
    } else { *(bf16x8*)(V_lds + (b) * SHM_V + vst0) = sr_[i].vs0;          \
    *(bf16x8*)(V_lds + (b) * SHM_V + vst1) = sr_[i].vs1; const int kc = sc * 2;               \
    *(bf16x8*)(K_lds + (b) * SHM_K + KSWZ(sr, kc)) = sr_[i].ks0;                       \
    *(bf16x8*)(K_lds + (b) * SHM_K + KSWZ(32 + sr, kc)) = sr_[i].ks1; } } while (0)
#define SWAIT() do { if constexpr (MLA) asm volatile("s_waitcnt vmcnt(3)" ::: "memory"); else asm volatile("s_waitcnt vmcnt(4)" ::: "memory"); } while (0)
#define RESC(a) do { if (__any((a) < 1.f)) { if (hi == 0) al_l[r32] = (a); asm volatile("s_waitcnt lgkmcnt(0)" ::: "memory"); \
    _Pragma("unroll") for (int d = 0; d < NDV; ++d) _Pragma("unroll") for (int r = 0; r < 16; ++r) o[d][r] *= al_l[crow(r, hi)]; } } while (0)
    f32x16 pA0, pA1, pB0, pB1; float mnA, mnB, alA, alB; bf16x8 pa0, pa1, pa2, pa3; const int NT = nkeys / KVBLK;
    constexpr int SE = 0, SO = SDEPTH - 1;
    SLOAD(SE, 0); asm volatile("s_waitcnt vmcnt(0)" ::: "memory"); SWRITE(0, SE); __syncthreads();
    qkt<NDQ>(pA0, pA1, K_lds, qr, r32, hi); partialSM(pA0, pA1, m_reg, mnA, alA, C, thr_raw);
    SLOAD(SO, KVBLK); if (2 < NT) SLOAD(SE, 2 * KVBLK);
    SWAIT(); SWRITE(1, SO); __syncthreads();
    for (int j = 1; j + 1 < NT; j += 2) {
        SBAR(); qkt<NDQ>(pB0, pB1, K_lds + SHM_K, qr, r32, hi);
        finishSM(pA0, pA1, alA, l_reg, pa0, pa1, pa2, pa3); SBAR();
        SLOAD(SO, (j + SDEPTH) * KVBLK); SBAR();
        pv_d0<NDV>(o, vb0, pa0, pa1, pa2, pa3); partialSM(pB0, pB1, m_reg, mnB, alB, C, thr_raw);
        __syncthreads(); SWAIT(); SWRITE(0, SE);
        RESC(alB); __syncthreads();
        SBAR(); qkt<NDQ>(pA0, pA1, K_lds, qr, r32, hi);
        finishSM(pB0, pB1, alB, l_reg, pa0, pa1, pa2, pa3); SBAR();
        if (j + 3 < NT) SLOAD(SE, (j + 1 + SDEPTH) * KVBLK); SBAR();
        pv_d0<NDV>(o, vb0 + (int)SHM_V, pa0, pa1, pa2, pa3); partialSM(pA0, pA1, m_reg, mnA, alA, C, thr_raw);
        __syncthreads(); SWAIT(); SWRITE(1, SO);
        RESC(alA); __syncthreads();
    }
    SBAR(); qkt<NDQ>(pB0, pB1, K_lds + SHM_K, qr, r32, hi);
    finishSM(pA0, pA1, alA, l_reg, pa0, pa1, pa2, pa3); SBAR();
    pv_d0<NDV>(o, vb0, pa0, pa1, pa2, pa3); partialSM(pB0, pB1, m_reg, mnB, alB, C, thr_raw);
    __syncthreads(); RESC(alB);
    finishSM(pB0, pB1, alB, l_reg, pa0, pa1, pa2, pa3); SBAR();
    pv_d0<NDV>(o, vb0 + (int)SHM_V, pa0, pa1, pa2, pa3);
    if (hi == 0) li_l[r32] = l_reg; asm volatile("s_waitcnt lgkmcnt(0)" ::: "memory");
    float rli[16];
#pragma unroll
    for (int r = 0; r < 16; ++r) rli[r] = __builtin_amdgcn_rcpf(li_l[crow(r, hi)]);
    bf16_t* Ow = Ob + (long)(wid * QBLK) * ldo;
#pragma unroll
    for (int r = 0; r < 16; ++r) { const int orow = crow(r, hi);
#pragma unroll
        for (int d0 = 0; d0 < NDV; ++d0) Ow[(long)orow * ldo + d0 * 32 + r32] = (bf16_t)(cvtpk(o[d0][r] * rli[r], 0.f) & 0xffffu); }
    asm volatile("s_waitcnt vmcnt(0) lgkmcnt(0)" ::: "memory");
    __syncthreads();
#undef SLOAD
#undef SWRITE
#undef SWAIT
#undef RESC
}
}

__device__ __forceinline__ void modulate_2rows(const float* xrow0, const float* xrow1, const float* shift, const float* scale, bf16_t* orow0, bf16_t* orow1, int ln) {
    const f32x4* xa = (const f32x4*)xrow0 + ln; const f32x4* xb = (const f32x4*)xrow1 + ln;
    f32x4 va[4], vb[4]; float sa = 0.f, sb = 0.f;
#pragma unroll
    for (int j = 0; j < 4; ++j) { va[j] = __builtin_nontemporal_load(xa + 64 * j); vb[j] = __builtin_nontemporal_load(xb + 64 * j); }
#pragma unroll
    for (int j = 0; j < 4; ++j) { sa += (va[j][0] * va[j][0] + va[j][1] * va[j][1]) + (va[j][2] * va[j][2] + va[j][3] * va[j][3]);
                                  sb += (vb[j][0] * vb[j][0] + vb[j][1] * vb[j][1]) + (vb[j][2] * vb[j][2] + vb[j][3] * vb[j][3]); }
#pragma unroll
    for (int o = 1; o < 64; o <<= 1) { sa += __shfl_xor(sa, o); sb += __shfl_xor(sb, o); }
    const float ra = rsqrtf(sa * (1.f / DM) + EPSN), rb = rsqrtf(sb * (1.f / DM) + EPSN);
    u32x2* oa = (u32x2*)orow0 + ln; u32x2* ob = (u32x2*)orow1 + ln;
#pragma unroll
    for (int j = 0; j < 4; ++j) { const f32x4 sh = ((const f32x4*)shift)[ln + 64 * j], sc = ((const f32x4*)scale)[ln + 64 * j] + 1.0f;
        const f32x4 ya = va[j] * ra * sc + sh, yb = vb[j] * rb * sc + sh;
        u32x2 w; w.x = cvt_pk_bf16(ya[0], ya[1]); w.y = cvt_pk_bf16(ya[2], ya[3]); oa[64 * j] = w;
        w.x = cvt_pk_bf16(yb[0], yb[1]); w.y = cvt_pk_bf16(yb[2], yb[3]); ob[64 * j] = w; }
}

template <class F>
__device__ __forceinline__ void tr_item(F ld, bf16_t* WT, int ldt, int k0, int n0, LAS float* scr, int lane) {
#pragma unroll 8
    for (int i = 0; i < 32; ++i) { const int kk = 2 * i + (lane >> 5); scr[kk * 33 + (lane & 31)] = ld(k0 + kk, n0 + (lane & 31)); }
    asm volatile("s_waitcnt lgkmcnt(0)" ::: "memory");
    const int c = lane & 7;
#pragma unroll
    for (int j = 0; j < 4; ++j) { const int n = (lane >> 3) + 8 * j; const LAS float* s = scr + (8 * c) * 33 + n;
        u32x4 o; o.x = cvt_pk_bf16(s[0 * 33], s[1 * 33]); o.y = cvt_pk_bf16(s[2 * 33], s[3 * 33]); o.z = cvt_pk_bf16(s[4 * 33], s[5 * 33]); o.w = cvt_pk_bf16(s[6 * 33], s[7 * 33]);
        *(u32x4*)(WT + (size_t)(n0 + n) * ldt + k0 + 8 * c) = o; }
    asm volatile("s_waitcnt lgkmcnt(0)" ::: "memory");
}

__device__ __forceinline__ void fix_edges(bf16_t* __restrict__ ACTp, const float* __restrict__ HALOp, const float* __restrict__ cw, int q, int e, int ln) {
    const int row = 64 * q + (e ? 63 : 0);
    const bool lat = row < RL; const int tpos = lat ? (row & (NSEQ - 1)) : ((row - RL) & (NCTX - 1)); const int T = lat ? NSEQ : NCTX;
    const bool has = e ? (tpos != T - 1) : (tpos != 0);
    const float* HPp = HALOp + (e ? 3 : 0) * HSZ + (size_t)q * DFF; const float* HUp = HALOp + (e ? 5 : 2) * HSZ + (size_t)q * DFF;
    const float* HGn = e ? HALOp + 1 * HSZ + (size_t)(q + 1) * DFF : HALOp + 4 * HSZ + (size_t)(q - 1) * DFF;
    const float* wv = cw + (e ? 2 : 0) * DFF;
#pragma unroll 4
    for (int jj = 0; jj < 11; ++jj) { const int c = (jj * 64 + ln) * 4;
        f32x4 pre = *(const f32x4*)(HPp + c);
        if (has) pre += *(const f32x4*)(wv + c) * *(const f32x4*)(HGn + c);
        const f32x4 uu = *(const f32x4*)(HUp + c);
        u32x2 w; w.x = cvt_pk_bf16(silu_f(pre[0]) * uu[0], silu_f(pre[1]) * uu[1]); w.y = cvt_pk_bf16(silu_f(pre[2]) * uu[2], silu_f(pre[3]) * uu[3]);
        *(u32x2*)(ACTp + (size_t)row * DFF + c) = w; }
}
__device__ __forceinline__ int launder_v(int v) { asm volatile("" : "+v"(v)); return v; }
__device__ __forceinline__ int launder_s(int v) { asm volatile("" : "+s"(v)); return v; }
#define XB_TMO      128
#define XB_XCNT(j)  (256  + 64 * (j))
#define XB_XSUB(j)  (1280 + 64 * (j))
#define XB_XGEN(j)  (2304 + 64 * (j))
#define XB_TOP      3328
#define XB_TOPGEN   3392
#define XCD_BAR_WORDS 3456
#define XB_SPIN_CAP (1u << 20)
__device__ __forceinline__ unsigned xb_ld(unsigned* p)              { return __hip_atomic_load(p, __ATOMIC_RELAXED, __HIP_MEMORY_SCOPE_AGENT); }
__device__ __forceinline__ unsigned xb_add(unsigned* p, unsigned v) { return __hip_atomic_fetch_add(p, v, __ATOMIC_RELAXED, __HIP_MEMORY_SCOPE_AGENT); }
__device__ __forceinline__ unsigned xb_xcc_id() { return (unsigned)__builtin_amdgcn_s_getreg((3 << 11) | 20) & 0xFu; }
#define XB_SPIN(cond, bar) do { unsigned _sp = 0; while (cond) { __builtin_amdgcn_s_sleep(1); \
    if ((++_sp & 255u) == 0u) { if (xb_ld(&(bar)[XB_TMO])) break; if (_sp > XB_SPIN_CAP) { atomicAdd(&(bar)[XB_TMO], 1u); break; } } } } while (0)
__device__ __forceinline__ void xcd_barrier_complete(unsigned* bar, unsigned x, unsigned& nloc, unsigned& nx) {
    const unsigned Gn = gridDim.x * gridDim.y * gridDim.z;
    unsigned sum, cnt, mine, sp = 0u;
    for (;;) {
        sum = 0u; cnt = 0u; mine = 0u;
#pragma unroll
        for (unsigned j = 0; j < 16; ++j) { const unsigned c = xb_ld(&bar[XB_XCNT(j)]); sum += c; cnt += (c > 0u) ? 1u : 0u; mine = (j == x) ? c : mine; }
        if (sum == Gn) break;
        __builtin_amdgcn_s_sleep(1);
        if ((++sp & 255u) == 0u) { if (xb_ld(&bar[XB_TMO])) break; if (sp > XB_SPIN_CAP) { atomicAdd(&bar[XB_TMO], 1u); break; } }
    }
    nloc = mine > 0u ? mine : 1u; nx = cnt > 0u ? cnt : 1u;
}
__device__ __forceinline__ void xcd_barrier(unsigned* bar, volatile LAS unsigned* st) {
    asm volatile("s_waitcnt vmcnt(0)" ::: "memory");
    __syncthreads();
    if (threadIdx.x == 0) {
        const unsigned x = xb_xcc_id();
        __builtin_amdgcn_s_waitcnt(0);
        unsigned nloc = st[0], nx = st[1];
        if (nloc == 0u) { xcd_barrier_complete(bar, x, nloc, nx); st[0] = nloc; st[1] = nx; }
        const unsigned old = xb_add(&bar[XB_XSUB(x)], 1u);
        const unsigned gen = old / nloc;
        if (old + 1u == (gen + 1u) * nloc) {
            __builtin_amdgcn_fence(__ATOMIC_RELEASE, "agent");
            asm volatile("s_waitcnt vmcnt(0)" ::: "memory");
            const unsigned og = xb_add(&bar[XB_TOP], 1u);
            const unsigned tg = og / nx;
            if (og + 1u == (tg + 1u) * nx) xb_add(&bar[XB_TOPGEN], 1u);
            else XB_SPIN(xb_ld(&bar[XB_TOPGEN]) == tg, bar);
            __builtin_amdgcn_fence(__ATOMIC_ACQUIRE, "agent");
            xb_add(&bar[XB_XGEN(x)], 1u);
            asm volatile("s_waitcnt vmcnt(0)" ::: "memory");
        } else {
            XB_SPIN(xb_ld(&bar[XB_XGEN(x)]) == gen, bar);
            __builtin_amdgcn_fence(__ATOMIC_ACQUIRE, "agent");
            asm volatile("s_waitcnt vmcnt(0)" ::: "memory");
        }
    }
    __syncthreads();
}

__global__ void __launch_bounds__(512, 2) fwd(Params p) {
    extern __shared__ __attribute__((aligned(16))) unsigned char lds[];
    cg::grid_group grid = cg::this_grid();
#define tid (launder_v((int)threadIdx.x))
#define lane (launder_v((int)threadIdx.x) & 63)
#define wave (__builtin_amdgcn_readfirstlane(launder_v((int)threadIdx.x) >> 6))
#define G (launder_s((int)gridDim.x))
#define bx (launder_s((int)blockIdx.x))
#define vcu ((bx & 7) * (G >> 3) + (bx >> 3))
#define gw (bx * 8 + wave)
#define NGW (G * 8)
#define ws (p.ws)
    {
        volatile LAS unsigned* st_ = (volatile LAS unsigned*)((LAS unsigned char*)lds + LDS_BARST);
        if (threadIdx.x == 0) { const unsigned xc_ = xb_xcc_id(); st_[0] = 0u; st_[1] = 0u; st_[2] = xb_add((unsigned*)(ws + WS_CTL) + XB_XCNT(xc_), 1u); st_[3] = xc_; }
        __syncthreads();
    }
#define GSYNC() xcd_barrier((unsigned*)(ws + WS_CTL), (volatile LAS unsigned*)((LAS unsigned char*)lds + LDS_BARST))
    LAS unsigned char* ldsL = (LAS unsigned char*)lds;

#define x_in (p.in[0])
#define c_in (p.in[1])
#define ctx_in (p.in[2])
#define cctx_in (p.in[3])
#define w_mod (p.in[4])
#define b_mod (p.in[5])
#define MOD ((float*)(ws + WS_MOD))
#define RS ((float*)(ws + WS_RS))
#define ROPEA ((float2*)(ws + WS_ROPEA))
#define ROPEC ((float2*)(ws + WS_ROPEC))
#define W_IN0 ((bf16_t*)(ws + WS_WIN0))
#define W_UQ ((bf16_t*)(ws + WS_WUQ))
#define W_UKV ((bf16_t*)(ws + WS_WUKV))
#define W_POOL ((bf16_t*)(ws + WS_WPOOL))
#define W_OUT0 ((bf16_t*)(ws + WS_WOUT0))
#define W_GIN ((bf16_t*)(ws + WS_WGIN))
#define W_GOUT ((bf16_t*)(ws + WS_WGOUT))
#define W_UP ((bf16_t*)(ws + WS_WUP))
#define W_DOWN ((bf16_t*)(ws + WS_WDOWN))
#define Hb ((bf16_t*)(ws + WS_H))
#define X1 ((float*)(ws + WS_X1))
#define X16 ((bf16_t*)(ws + WS_X1))
#define V0 ((bf16_t*)(ws + WS_V0))
#define DP ((bf16_t*)(ws + WS_DP))
#define CAT ((bf16_t*)(ws + WS_CAT))
#define Q0 ((bf16_t*)(ws + WS_Q0))
#define K0 ((bf16_t*)(ws + WS_K0))
#define PL ((bf16_t*)(ws + WS_PL))
#define ACT ((bf16_t*)(ws + WS_ACT))
#define HALO ((float*)(ws + WS_HALO))
#define PG ((bf16_t*)(ws + WS_PG))
#define CAT1 ((bf16_t*)(ws + WS_CAT1))
#ifndef PHMASK
#define PHMASK 0xFFFFFFFFu
#endif
#ifndef DUPMASK
#define DUPMASK 0u
#endif
#define PH(k) _Pragma("unroll 1") for (int rep_ = 0; rep_ < (int)(((PHMASK >> (k)) & 1u) + ((DUPMASK >> (k)) & 1u)); ++rep_)

#define CV_I_IN0 (16 * 40)
#define CV_I_UQ (6 * 24)
#define CV_I_UKV (4 * 32)
#define CV_I_POOL (8 * 16)
#define CV_I_OUT0 (16 * 32)
#define CV_I_GIN (16 * 48)
#define CV_I_GOUT (16 * 32)
#define CV_I_UP (16 * 176)
#define CV_I_DOWN (44 * 32)
#define CV_A_END (CV_I_IN0 + CV_I_UQ + CV_I_UKV + CV_I_POOL + CV_I_OUT0)
#define CV_B_END (CV_A_END + CV_I_UP + CV_I_DOWN)
#define CV_C_END (CV_B_END + CV_I_GIN + CV_I_GOUT + CV_I_UP + CV_I_DOWN)
#define CONVERT_ITEM(it_) do { int r = (it_); LAS float* scr = (LAS float*)(ldsL + wave * 16384); const int ln_ = lane; \
        if (r < CV_I_IN0) { const int kb = r / 40, nb = r % 40; const float* w_in0 = p.in[6]; \
            tr_item([=](int k, int n) { return n < 1184 ? w_in0[(size_t)k * 1184 + n] : 0.f; }, W_IN0, 1024, kb * 64, nb * 32, scr, ln_); break; } r -= CV_I_IN0; \
        if (r < CV_I_UQ) { const int kb = r / 24, nb = r % 24; const float* g_q0 = p.in[7]; const float* w_uq = p.in[8]; \
            tr_item([=](int k, int n) { return g_q0[k] * w_uq[(size_t)k * 768 + n]; }, W_UQ, 384, kb * 64, nb * 32, scr, ln_); break; } r -= CV_I_UQ; \
        if (r < CV_I_UKV) { const int kb = r / 32, nb = r % 32; const float* g_kv0 = p.in[9]; const float* w_uk = p.in[10]; const float* w_uv = p.in[11]; \
            tr_item([=](int k, int n) { return g_kv0[k] * (n < 512 ? w_uk[(size_t)k * 512 + n] : w_uv[(size_t)k * 512 + n - 512]); }, W_UKV, 256, kb * 64, nb * 32, scr, ln_); break; } r -= CV_I_UKV; \
        if (r < CV_I_POOL) { const int kb = r / 16, nb = r % 16; const float* pool_w = p.in[12]; const float* pool_s = p.in[13]; \
            tr_item([=](int k, int n) { return ((k >> 7) == (n >> 7)) ? pool_w[(size_t)(k >> 7) * 16384 + (k & 127) * 128 + (n & 127)] * pool_s[n] : 0.f; }, W_POOL, 512, kb * 64, nb * 32, scr, ln_); break; } r -= CV_I_POOL; \
        if (r < CV_I_OUT0) { const int kb = r / 32, nb = r % 32; const float* w_out0 = p.in[14]; \
            tr_item([=](int k, int n) { return w_out0[(size_t)k * 1024 + n]; }, W_OUT0, 1024, kb * 64, nb * 32, scr, ln_); break; } r -= CV_I_OUT0; \
        if (r < CV_I_UP) { const int kb = r / 176, nb = r % 176; const float* W = p.in[19]; \
            tr_item([=](int k, int n) { return W[(size_t)k * 5632 + ((n >> 7) & 1) * DFF + (n >> 8) * 128 + (n & 127)]; }, W_UP, 1024, kb * 64, nb * 32, scr, ln_); break; } r -= CV_I_UP; \
        if (r < CV_I_DOWN) { const int kb = r / 32, nb = r % 32; const float* W = p.in[22]; \
            tr_item([=](int k, int n) { return W[(size_t)k * 1024 + n]; }, W_DOWN, DFF, kb * 64, nb * 32, scr, ln_); break; } r -= CV_I_DOWN; \
        if (r < CV_I_GIN) { const int kb = r / 48, nb = r % 48; const float* gqa_w_in = p.in[15]; \
            tr_item([=](int k, int n) { return gqa_w_in[(size_t)k * 1536 + n]; }, W_GIN, 1024, kb * 64, nb * 32, scr, ln_); break; } r -= CV_I_GIN; \
        if (r < CV_I_GOUT) { const int kb = r / 32, nb = r % 32; const float* gqa_w_out = p.in[18]; \
            tr_item([=](int k, int n) { return gqa_w_out[(size_t)k * 1024 + n]; }, W_GOUT, 1024, kb * 64, nb * 32, scr, ln_); break; } r -= CV_I_GOUT; \
        if (r < CV_I_UP) { const int kb = r / 176, nb = r % 176; const float* W = p.in[19] + (size_t)1024 * 5632; \
            tr_item([=](int k, int n) { return W[(size_t)k * 5632 + ((n >> 7) & 1) * DFF + (n >> 8) * 128 + (n & 127)]; }, W_UP + (size_t)5632 * 1024, 1024, kb * 64, nb * 32, scr, ln_); break; } r -= CV_I_UP; \
        { const int kb = r / 32, nb = r % 32; const float* W = p.in[22] + (size_t)DFF * 1024; \
            tr_item([=](int k, int n) { return W[(size_t)k * 1024 + n]; }, W_DOWN + (size_t)1024 * DFF, DFF, kb * 64, nb * 32, scr, ln_); } \
    } while (0)
#define DRAIN_CONVERT(cid_, skip_, lo, hi) do { const int c_ = (cid_), nb_ = G - (skip_);   \
        if (c_ >= (skip_)) for (int it_q = (lo) + (c_ - (skip_)) * 8 + wave; it_q < (hi); it_q += nb_ * 8) CONVERT_ITEM(it_q); } while (0)

    PH(0) {
        if (bx < 96) {
            const int layer = bx / 48, col0 = (bx % 48) * 128;
            LAS float* sv = (LAS float*)ldsL; LAS float* red = sv + 5120;
            for (int i = tid; i < 5120; i += 512) { const int v = i >> 10, k = i & 1023; const float cv = v < 4 ? c_in[v * 1024 + k] : cctx_in[k];
                sv[i] = cv / (1.0f + __expf(-cv)); }
            __syncthreads();
            const float* W = w_mod + (size_t)layer * 1024 * 6144 + col0 + 2 * lane;
            float a0[5] = {0.f, 0.f, 0.f, 0.f, 0.f}, a1[5] = {0.f, 0.f, 0.f, 0.f, 0.f};
#pragma unroll 32
            for (int kk = 0; kk < 128; ++kk) { const int k = wave * 128 + kk; const float2 w = *(const float2*)(W + (size_t)k * 6144);
#pragma unroll
                for (int v = 0; v < 5; ++v) { const float s = sv[v * 1024 + k]; a0[v] += s * w.x; a1[v] += s * w.y; } }
#pragma unroll
            for (int v = 0; v < 5; ++v) { red[(wave * 5 + v) * 128 + 2 * lane] = a0[v]; red[(wave * 5 + v) * 128 + 2 * lane + 1] = a1[v]; }
            __syncthreads();
            for (int i = tid; i < 640; i += 512) { const int v = i >> 7, cc = i & 127; float s = b_mod[layer * 6144 + col0 + cc];
#pragma unroll
                for (int w = 0; w < 8; ++w) s += red[(w * 5 + v) * 128 + cc];
                MOD[(size_t)(layer * 5 + v) * 6144 + col0 + cc] = s; }
            __syncthreads();
        }
        for (int idx = bx * 512 + tid; idx < NSEQ * 80; idx += G * 512) {
            const int t = idx / 80, j = idx % 80; const int prow = t >> 6, pcol = t & 63;
            float pos, fe;
            if (j < 16) { pos = (float)((j < 8) ? prow : pcol); fe = (float)(j & 7) * (1.0f / 8.0f); }
            else { const int jj = j - 16; pos = (float)((jj < 32) ? prow : pcol); fe = (float)(jj & 31) * (1.0f / 32.0f); }
            const float freq = exp2f(-fe * 13.287712379549449f);
            const float ang = pos * freq;
            const float kq = rintf(ang * 0.15915494309189535f);
            float rr = fmaf(-kq, 6.2831854820251465f, ang); rr = fmaf(-kq, -1.7484555e-7f, rr);
            float2 cs; cs.x = __cosf(rr); cs.y = __sinf(rr);
            if (j < 16) ROPEA[(size_t)t * 16 + j] = cs; else ROPEC[(size_t)t * 64 + (j - 16)] = cs;
        }
        DRAIN_CONVERT(bx, 96, 0, CV_A_END);
    }
    if (p.out == nullptr) grid.sync();
    GSYNC();
    {
        volatile LAS unsigned* st_ = (volatile LAS unsigned*)((LAS unsigned char*)lds + LDS_BARST);
        if (threadIdx.x == 0) {
            unsigned* bar_ = (unsigned*)(ws + WS_CTL); const unsigned Gn = gridDim.x; bool uni = (Gn % 8u) == 0u;
#pragma unroll
            for (unsigned j = 0; j < 16; ++j) { const unsigned c = xb_ld(&bar_[XB_XCNT(j)]); if (c != (j < 8u ? Gn / 8u : 0u)) uni = false; }
            const unsigned tk = st_[2], xc = st_[3], b_ = blockIdx.x;
            st_[4] = uni ? tk * 8u + xc : b_;
            st_[5] = uni ? xc * (Gn / 8u) + tk : ((Gn % 8u) == 0u ? (b_ & 7u) * (Gn >> 3) + (b_ >> 3) : b_);
        }
        __syncthreads();
    }
#define XCH_ARGS(k_) (unsigned*)(ws + WS_XSLOT), (unsigned*)(ws + WS_CTL) + CW_PANEL, 32u * (k_), (LAS unsigned char*)lds + LDS_XCH, (float*)(ws + WS_SLAB), (unsigned*)(ws + WS_CTL) + CW_SLAB, (unsigned)(k_)
#define CID ((int)__builtin_amdgcn_readfirstlane(((volatile LAS unsigned*)((LAS unsigned char*)lds + LDS_BARST))[4]))
#define VID ((int)__builtin_amdgcn_readfirstlane(((volatile LAS unsigned*)((LAS unsigned char*)lds + LDS_BARST))[5]))

    PH(1) for (int r = 2 * gw; r < RT; r += 2 * NGW) {
        const int v = r < RL ? (r >> 13) : 4; const float* xr = r < RL ? x_in + (size_t)r * DM : ctx_in + (size_t)(r - RL) * DM;
        modulate_2rows(xr, xr + DM, MOD + (size_t)(v * 6 + 0) * DM, MOD + (size_t)(v * 6 + 1) * DM, Hb + (size_t)r * DM, Hb + (size_t)(r + 1) * DM, lane);
    }
    GSYNC();

    PH(2) {
        pg8::Gemm g{Hb, W_IN0, RT, NIN0, 1024, 1024, 1024}; pg8::StaticOrder S; S.init(RT, NIN0, G, CID);
        pg8::EpiStore E{PL, NIN0};
        pg8::gemm_phase<pg8::EpiStore, pg8::StaticOrder>(ldsL, g, S, E);
    }
    GSYNC();

    PH(3) for (int r = 2 * gw; r < RT; r += 2 * NGW) {
        const bf16_t* pr = PL + (size_t)r * NIN0;
        const bool lat = r < RL;
        const int i16 = lane & 15, hq = lane >> 4, half = 1 << hq;
        const int t = lat ? (r & (NSEQ - 1)) : ((r - RL) & (NCTX - 1)); const int T = lat ? NSEQ : NCTX;
        const u32x4 a0 = *(const u32x4*)(pr + 8 * lane), a1 = *(const u32x4*)(pr + NIN0 + 8 * lane);
        u32x4 b0 = {0u, 0u, 0u, 0u}, b1 = {0u, 0u, 0u, 0u};
        if (lane < 16) { b0 = *(const u32x4*)(pr + 512 + 8 * lane); b1 = *(const u32x4*)(pr + NIN0 + 512 + 8 * lane); }
        const unsigned kw0 = *(const unsigned*)(pr + 640 + 2 * i16), kw1 = *(const unsigned*)(pr + NIN0 + 640 + 2 * i16);
        float2 cs0, cs1; cs0.x = 1.f; cs0.y = 0.f; cs1 = cs0;
        if (lat) { cs0 = ROPEA[(size_t)t * 16 + i16]; cs1 = ROPEA[(size_t)(t + 1) * 16 + i16]; }
        const bf16_t* pp = pr + 672 + 8 * lane;
        u32x4 w[17];
#pragma unroll
        for (int k = 0; k < 17; ++k) { const int dt = k - 8; const bool need = (dt >= -half) && (dt <= half) && (t + dt >= 0) && (t + dt < T);
            w[k] = (u32x4){0u, 0u, 0u, 0u}; if (need) w[k] = *(const u32x4*)(pp + dt * NIN0); }
        {
            float s0 = 0.f, s1 = 0.f, u0 = 0.f, u1 = 0.f;
#pragma unroll
            for (int e = 0; e < 4; ++e) { float lo = bf_lo(a0[e]), hi = bf_hi(a0[e]); s0 += lo * lo + hi * hi; lo = bf_lo(a1[e]); hi = bf_hi(a1[e]); s1 += lo * lo + hi * hi;
                                          lo = bf_lo(b0[e]); hi = bf_hi(b0[e]); u0 += lo * lo + hi * hi; lo = bf_lo(b1[e]); hi = bf_hi(b1[e]); u1 += lo * lo + hi * hi; }
            float q0 = lane < 48 ? s0 : 0.f, q1 = lane < 48 ? s1 : 0.f, k0 = (lane < 48 ? 0.f : s0) + u0, k1 = (lane < 48 ? 0.f : s1) + u1;
#pragma unroll
            for (int o = 1; o < 64; o <<= 1) { q0 += __shfl_xor(q0, o); q1 += __shfl_xor(q1, o); k0 += __shfl_xor(k0, o); k1 += __shfl_xor(k1, o); }
            if (lane == 0) { f32x4 rs; rs[0] = rsqrtf(q0 * (1.f / 384.f) + EPSN); rs[1] = rsqrtf(k0 * (1.f / 256.f) + EPSN); rs[2] = rsqrtf(q1 * (1.f / 384.f) + EPSN); rs[3] = rsqrtf(k1 * (1.f / 256.f) + EPSN);
                             *(f32x4*)(RS + 2 * r) = rs; }
        }
        {
            const float x0 = bf_lo(kw0), x1 = bf_hi(kw0), z0 = bf_lo(kw1), z1 = bf_hi(kw1);
            const unsigned o0 = cvt_pk_bf16(x0 * cs0.x - x1 * cs0.y, x0 * cs0.y + x1 * cs0.x), o1 = cvt_pk_bf16(z0 * cs1.x - z1 * cs1.y, z0 * cs1.y + z1 * cs1.x);
            bf16_t* kd = K0 + (size_t)r * 768 + hq * 96 + 64 + 2 * i16;
            *(unsigned*)(kd) = o0; *(unsigned*)(kd + 4 * 96) = o0; *(unsigned*)(kd + 768) = o1; *(unsigned*)(kd + 768 + 4 * 96) = o1;
        }
        {
            float acc0[8] = {0.f, 0.f, 0.f, 0.f, 0.f, 0.f, 0.f, 0.f}, acc1[8] = {0.f, 0.f, 0.f, 0.f, 0.f, 0.f, 0.f, 0.f}; float c0 = 0.f, c1 = 0.f;
#pragma unroll
            for (int k = 0; k < 17; ++k) { const int dt = k - 8; const bool val = (t + dt >= 0) && (t + dt < T);
                const bool in0 = val && (dt >= -half) && (dt < half), in1 = val && (dt >= 1 - half) && (dt <= half);
                const float m0 = in0 ? 1.f : 0.f, m1 = in1 ? 1.f : 0.f; c0 += m0; c1 += m1;
#pragma unroll
                for (int e = 0; e < 4; ++e) { const float lo = bf_lo(w[k][e]), hi = bf_hi(w[k][e]);
                    acc0[2 * e] += m0 * lo; acc0[2 * e + 1] += m0 * hi; acc1[2 * e] += m1 * lo; acc1[2 * e + 1] += m1 * hi; } }
            const float ic0 = 1.0f / c0, ic1 = 1.0f / c1;
            u32x4 d0, d1;
#pragma unroll
            for (int e = 0; e < 4; ++e) { d0[e] = cvt_pk_bf16(acc0[2 * e] * ic0 - bf_lo(w[8][e]), acc0[2 * e + 1] * ic0 - bf_hi(w[8][e]));
                                          d1[e] = cvt_pk_bf16(acc1[2 * e] * ic1 - bf_lo(w[9][e]), acc1[2 * e + 1] * ic1 - bf_hi(w[9][e])); }
            *(u32x4*)(DP + (size_t)r * 512 + 8 * lane) = d0; *(u32x4*)(DP + (size_t)(r + 1) * 512 + 8 * lane) = d1;
        }
    }
    GSYNC();

    PH(4) {
#ifndef P4SEL
#define P4SEL 7
#endif
        if constexpr (P4SEL & 1) { pg8::Gemm g{PL, W_UQ, RT, 768, 384, NIN0, 384}; pg8::StaticOrder S; S.init(RT, 768, G, CID);
          pg8::EpiQ0 E{Q0, RS};
          pg8::gemm_phase<pg8::EpiQ0, pg8::StaticOrder>(ldsL, g, S, E); }
        if constexpr (P4SEL & 2) { pg8::Gemm g{PL + 384, W_UKV, RT, 1024, 256, NIN0, 256}; pg8::StaticOrder S; S.init(RT, 1024, G, CID);
          pg8::EpiKV0 E{K0, V0, RS};
          pg8::gemm_phase<pg8::EpiKV0, pg8::StaticOrder>(ldsL, g, S, E); }
        if constexpr (P4SEL & 4) { pg8::Gemm g{DP, W_POOL, RT, 512, 512, 512, 512}; pg8::StaticOrder S; S.init(RT, 512, G, CID);
          pg8::EpiStore E{CAT + 512, DM};
          pg8::gemm_phase<pg8::EpiStore, pg8::StaticOrder>(ldsL, g, S, E); }
    }
    GSYNC();

    PH(5) {
        const float scale = 0.10206207261596577f;
        const float C = scale * 1.4426950408889634f, thr = 8.0f / scale;
        if (bx < 32) {
            const int b = bx >> 3, h = bx & 7; const size_t r0 = (size_t)RL + b * NCTX;
            att::attn_unit<6, 2>(Q0 + r0 * 768 + h * 96, 768, K0 + r0 * 768 + h * 96, K0, 768, V0 + r0 * 512 + h * 64, V0, 512,
                                 CAT + r0 * DM + h * 64, DM, NCTX, NCTX, C, thr, (char*)lds);
        }
        for (int U = VID; U < 1024; U += G) {
            const int qb = U & 31, bh = U >> 5, h = bh & 7, b = bh >> 3;
            const size_t rc = (size_t)RL + b * NCTX, rl = (size_t)b * NSEQ, rq = rl + qb * 256;
            att::attn_unit<6, 2>(Q0 + rq * 768 + h * 96, 768, K0 + rc * 768 + h * 96, K0 + rl * 768 + h * 96, 768,
                                 V0 + rc * 512 + h * 64, V0 + rl * 512 + h * 64, 512, CAT + rq * DM + h * 64, DM, NCTX + NSEQ, NCTX, C, thr, (char*)lds, ROPEA, qb * 256);
        }
    }
    GSYNC();

    PH(6) {
        pg8::Gemm g{CAT, W_OUT0, RT, 1024, 1024, 1024, 1024}; pg8::AlignedOrder S; S.init(RT, 1024, G, CID, 16);
        pg8::EpiResidMod E{x_in, ctx_in, nullptr, X16, MOD, 2, MOD, 3, Hb, nullptr, nullptr, XCH_ARGS(1)};
        pg8::gemm_phase<pg8::EpiResidMod, pg8::AlignedOrder>(ldsL, g, S, E);
        DRAIN_CONVERT(CID, 32, CV_A_END, CV_B_END);
    }
    GSYNC();

#define FFN_BLOCK(layer) do { \
        const int rows = (layer) == 0 ? RT : RL; const float* modL = MOD + (size_t)(layer) * 5 * 6144; \
        PH(8) { pg8::Gemm g{Hb, W_UP + (size_t)layer * 5632 * 1024, rows, 5632, 1024, 1024, 1024}; pg8::StaticOrder S; S.init(rows, 5632, G, CID); \
          pg8::EpiFFN E{ACT, HALO, p.in[20] + (size_t)layer * 3 * DFF, p.in[21] + (size_t)layer * DFF}; \
          pg8::gemm_phase<pg8::EpiFFN, pg8::StaticOrder>(ldsL, g, S, E); } \
        GSYNC(); \
        PH(10) { \
          { pg8::AlignedOrder S0; S0.init(rows, 1024, G, CID, 44); pg8::Unit uu_; \
            _Pragma("unroll 1") for (int ui_ = 0; S0.next(ui_, uu_); ++ui_) fix_edges(ACT, HALO, p.in[20] + (size_t)layer * 3 * DFF, 4 * uu_.pm + (wave >> 1), wave & 1, lane); \
            asm volatile("s_waitcnt vmcnt(0)" ::: "memory"); __syncthreads(); } \
          { pg8::Gemm g{ACT, W_DOWN + (size_t)layer * 1024 * DFF, rows, 1024, DFF, DFF, DFF}; pg8::AlignedOrder S; S.init(rows, 1024, G, CID, 44); \
          pg8::EpiResidMod E{nullptr, nullptr, X16, (layer) == 0 ? X16 : nullptr, modL, 5, MOD + (size_t)5 * 6144, 0, Hb, (layer) == 0 ? nullptr : p.in[23], p.out, XCH_ARGS((layer) == 0 ? 2 : 4)}; \
          pg8::gemm_phase<pg8::EpiResidMod, pg8::AlignedOrder>(ldsL, g, S, E); } \
          if ((layer) == 0) DRAIN_CONVERT(CID, 32, CV_B_END, CV_C_END); } \
        if ((layer) == 0) GSYNC(); \
    } while (0)
    FFN_BLOCK(0);
    {
        const float* modL = MOD + (size_t)5 * 6144;
            PH(12) { pg8::Gemm g{Hb, W_GIN, RT, 1536, 1024, 1024, 1024}; pg8::StaticOrder S; S.init(RT, 1536, G, CID);
              pg8::EpiQKNorm E{PG, p.in[16], p.in[17], ROPEC, (LAS unsigned char*)lds + LDS_XCH};
              pg8::gemm_phase<pg8::EpiQKNorm, pg8::StaticOrder>(ldsL, g, S, E); }
            GSYNC();
            PH(14) {
                const float scale = 0.08838834764831845f;
                const float C = scale * 1.4426950408889634f, thr = 8.0f / scale;
                for (int U = VID; U < 1024; U += G) {
                    const int qb = U & 31, bh = U >> 5, h = bh & 7, b = bh >> 3, kvh = h >> 2;
                    const size_t rc = (size_t)RL + b * NCTX, rl = (size_t)b * NSEQ, rq = rl + qb * 256;
                    att::attn_unit<8, 4>(PG + rq * 1536 + h * 128, 1536, PG + rc * 1536 + 1024 + kvh * 128, PG + rl * 1536 + 1024 + kvh * 128, 1536,
                                         PG + rc * 1536 + 1280 + kvh * 128, PG + rl * 1536 + 1280 + kvh * 128, 1536, CAT1 + rq * DM + h * 128, DM, NCTX + NSEQ, NCTX, C, thr, (char*)lds);
                }
            }
            GSYNC();
            PH(15) { pg8::Gemm g{CAT1, W_GOUT, RL, 1024, 1024, 1024, 1024}; pg8::AlignedOrder S; S.init(RL, 1024, G, CID);
              pg8::EpiResidMod E{nullptr, nullptr, X16, X16, modL, 2, modL, 3, Hb, nullptr, nullptr, XCH_ARGS(3)};
              pg8::gemm_phase<pg8::EpiResidMod, pg8::AlignedOrder>(ldsL, g, S, E); }
            GSYNC();
    }
    FFN_BLOCK(1);

}

#undef tid
#undef lane
#undef wave
#undef G
#undef bx
#undef vcu
#undef gw
#undef NGW
#undef ws
#undef X16
#undef GSYNC
#undef CID
#undef XCH_ARGS
#undef VID
#undef MOD
#undef RS
#undef x_in
#undef c_in
#undef ctx_in
#undef cctx_in
#undef w_mod
#undef b_mod
extern "C" void kernel_launch(void* const* d_in, const int* in_sizes, int n_in, void* d_out, int out_size, void* d_ws, size_t ws_size, hipStream_t stream) {
    static int grid = 0;
    if (grid == 0) {
        if (n_in != 24 || out_size != RL * DM || ws_size < WS_END) { fprintf(stderr, "kernel_launch: unexpected shapes n_in %d out %d ws %zu (need %zu)\n", n_in, out_size, ws_size, (size_t)WS_END); grid = -1; return; }
        int dev = 0, cus = 0, per_cu = 0;
        if (hipGetDevice(&dev) != hipSuccess || hipDeviceGetAttribute(&cus, hipDeviceAttributeMultiprocessorCount, dev) != hipSuccess) { grid = -1; return; }
        if (hipFuncSetAttribute((const void*)fwd, hipFuncAttributeMaxDynamicSharedMemorySize, LDS_BYTES) != hipSuccess) { fprintf(stderr, "kernel_launch: hipFuncSetAttribute failed\n"); grid = -1; return; }
        if (hipOccupancyMaxActiveBlocksPerMultiprocessor(&per_cu, (const void*)fwd, 512, LDS_BYTES) != hipSuccess || per_cu < 1) fprintf(stderr, "kernel_launch: occupancy query says %d\n", per_cu);
        (void)hipGetLastError();
        grid = cus;
    }
    if (grid < 0) return;
    Params p{};
    for (int i = 0; i < 24; ++i) p.in[i] = (const float*)d_in[i];
    p.out = (float*)d_out; p.ws = (unsigned char*)d_ws;
    if (hipMemsetAsync((char*)d_ws + WS_CTL, 0, CTL_BYTES, stream) != hipSuccess) { fprintf(stderr, "kernel_launch: memset failed\n"); return; }
    void* args[] = {&p};
    hipError_t e = hipLaunchCooperativeKernel((const void*)fwd, dim3(grid), dim3(512), args, LDS_BYTES, stream);
    if (e != hipSuccess) fprintf(stderr, "kernel_launch: cooperative launch failed: %s (grid %d)\n", hipGetErrorString(e), grid);
}
```

```cpp
#include <hip/hip_runtime.h>
#include <hip/hip_cooperative_groups.h>
#include <cstdio>
#include <cstdint>
namespace cg = cooperative_groups;

#define LAS __attribute__((address_space(3)))
typedef unsigned short bf16_t;
typedef short bf16x8 __attribute__((ext_vector_type(8)));
typedef short s16x4 __attribute__((ext_vector_type(4)));
typedef float f32x4 __attribute__((ext_vector_type(4)));
typedef float f32x16 __attribute__((ext_vector_type(16)));
typedef unsigned u32x4 __attribute__((ext_vector_type(4)));
typedef unsigned u32x2 __attribute__((ext_vector_type(2)));

constexpr int DM = 1024, NB = 4, NSEQ = 8192, NCTX = 256;
constexpr int RL = NB * NSEQ;
constexpr int RT = RL + NB * NCTX;
constexpr int DFF = 2816;
constexpr int NIN0 = 1280;
constexpr float EPSN = 1e-6f;

constexpr size_t MiB = 1u << 20;
constexpr size_t WS_MOD = 0;
constexpr size_t WS_RS = 512 * 1024;
constexpr size_t WS_ROPEA = 1 * MiB;
constexpr size_t WS_ROPEC = 2 * MiB;
constexpr size_t WS_CTL = 6 * MiB;
constexpr size_t CTL_BYTES = 65536;
constexpr int CW_PANEL = 4096;
constexpr int LDS_XCH = 131072 + 256;
constexpr int LDS_BARST = 131072 + 64;
constexpr size_t WS_WIN0 = 8 * MiB;
constexpr size_t WS_WUQ = WS_WIN0 + (size_t)1280 * 1024 * 2;
constexpr size_t WS_WUKV = 11 * MiB + 256 * 1024;
constexpr size_t WS_WPOOL = WS_WUKV + 512 * 1024;
constexpr size_t WS_WOUT0 = WS_WPOOL + 512 * 1024;
constexpr size_t WS_WGIN = WS_WOUT0 + 2 * MiB;
constexpr size_t WS_WGOUT = WS_WGIN + 3 * MiB;
constexpr size_t WS_WUP = WS_WGOUT + 2 * MiB;
constexpr size_t WS_WDOWN = WS_WUP + 22 * MiB;
static_assert(WS_WDOWN + 11 * MiB <= 56 * MiB, "weights");
constexpr size_t WS_H = 56 * MiB;
constexpr size_t WS_X1 = 122 * MiB;
constexpr size_t WS_V0 = 122 * MiB;
constexpr size_t WS_DP = 155 * MiB;
constexpr size_t WS_CAT = 254 * MiB;
constexpr size_t WS_Q0 = 320 * MiB;
constexpr size_t WS_K0 = WS_Q0 + (size_t)RT * 768 * 2;
constexpr size_t WS_PL = 419 * MiB;
constexpr size_t WS_ACT = 254 * MiB;
constexpr size_t WS_HALO = 436 * MiB;
constexpr size_t WS_XSLOT = 472 * MiB;
constexpr size_t WS_SLAB = 474 * MiB;
constexpr int CW_SLAB = 14336;
constexpr size_t WS_PG = 254 * MiB;
constexpr size_t WS_CAT1 = 353 * MiB;
constexpr size_t WS_END = 512 * MiB;
constexpr size_t HSZ = (size_t)528 * DFF;
static_assert(WS_K0 + (size_t)RT * 768 * 2 <= WS_PL && WS_PL + (size_t)RT * 1280 * 2 <= WS_END, "L0 map");
static_assert(WS_ACT + (size_t)RT * DFF * 2 <= WS_HALO && WS_HALO + 6 * HSZ * 4 <= WS_END, "FFN map");

constexpr int LDS_BYTES = 147456;

struct Params {
    const float* in[24];
    float* out;
    unsigned char* ws;
};

__device__ __forceinline__ unsigned cvt_pk_bf16(float lo, float hi) { unsigned r; asm volatile("v_cvt_pk_bf16_f32 %0, %1, %2" : "=v"(r) : "v"(lo), "v"(hi)); return r; }
__device__ __forceinline__ float bf_lo(unsigned w) { return __uint_as_float(w << 16); }
__device__ __forceinline__ float bf_hi(unsigned w) { return __uint_as_float(w & 0xffff0000u); }
__device__ __forceinline__ float wave_sum(float v) {
#pragma unroll
    for (int o = 1; o < 64; o <<= 1) v += __shfl_xor(v, o);
    return v;
}
__device__ __forceinline__ float silu_f(float x) { return x * __builtin_amdgcn_rcpf(1.0f + __builtin_amdgcn_exp2f(-1.4426950408889634f * x)); }

namespace pg8 {
constexpr int BM = 256, BK = 64, HALF = 128, HTB = HALF * BK * 2, STAGE_BYTES = 8 * HTB, NXCD = 8, WGM = 8;
__host__ __device__ __forceinline__ int lds_byte(int r, int c) { const int st = (r >> 4) * 2 + (c >> 5), rr = r & 15, cc = c & 31, ob = rr * 64 + cc * 2; return st * 1024 + (ob ^ (((ob >> 9) & 1) << 5)); }
__host__ __device__ __forceinline__ void stage_rc(int b, int& R, int& C) { const int st = b / 1024, sb = b % 1024, swz = sb ^ (((sb >> 9) & 1) << 5); R = (st >> 1) * 16 + swz / 64; C = (st & 1) * 32 + (swz % 64) / 2; }
__host__ __device__ __forceinline__ int perm32(int rho) { const int n = rho >> 4, i = rho & 15; return 8 * (i >> 2) + 4 * n + (i & 3); }

struct Unit { int pm, pn, kt0, nkt, kh; };
struct Gemm { const bf16_t* A; const bf16_t* Bt; int M, N, K, lda, ldb; };

struct StaticOrder {
    int nM, nN, nwg, G, c;
    __host__ __device__ __forceinline__ void init(int M, int N, int G_, int c_) { nM = M / BM; nN = N / BM; nwg = nM * nN; G = G_; c = c_; }
    __host__ __device__ __forceinline__ bool next(int i, Unit& u) const {
        const long L = (long)i * G + c; if (L >= nwg) return false;
        int wgid = (int)L; { const int q = nwg / NXCD, r = nwg % NXCD, xcd = wgid % NXCD, off = wgid / NXCD; wgid = (xcd < r ? xcd * (q + 1) : r * (q + 1) + (xcd - r) * q) + off; }
        const int nig = WGM * nN, gid = wgid / nig, fm = gid * WGM, gsz = (nM - fm) < WGM ? (nM - fm) : WGM;
        u.pm = fm + ((wgid % nig) % gsz); u.pn = (wgid % nig) / gsz; u.kt0 = 0; u.nkt = 0; u.kh = -1; return true;
    }
};

struct AlignedOrder {
    int nM, nN, nwg, G, c, nmain, ntk;
    __host__ __device__ __forceinline__ void init(int M, int N, int G_, int c_, int ntk_ = 0) { nM = M / BM; nN = N / BM; nwg = nM * nN; G = G_; c = c_; ntk = ntk_; const int blk = NXCD * WGM * nN; nmain = (nwg / blk) * blk; }
    __host__ __device__ __forceinline__ bool next(int i, Unit& u) const {
        const long L = (long)i * G + c; const int ntail = nwg - nmain; if (L >= nmain + (ntk ? 2 : 1) * ntail) return false;
        int wgid = (int)L; u.kt0 = 0; u.nkt = 0; u.kh = -1;
        if (wgid < nmain) { const int q = nmain / NXCD; wgid = (wgid % NXCD) * q + wgid / NXCD; }
        else if (ntk) { const int j = wgid - nmain; wgid = nmain + (j >> 1); u.kh = j & 1; u.nkt = ntk >> 1; u.kt0 = u.kh * u.nkt; }
        const int nig = WGM * nN, gid = wgid / nig, fm = gid * WGM, gsz = (nM - fm) < WGM ? (nM - fm) : WGM;
        u.pm = fm + ((wgid % nig) % gsz); u.pn = (wgid % nig) / gsz; return true;
    }
};

template <class Epi, class Sched, bool ALIGN_EPI = true, bool SP2 = true>
__device__ __forceinline__ void gemm_phase(LAS unsigned char* lds, const Gemm g, const Sched& S, const Epi& E) {
    int tid = threadIdx.x; asm volatile("" : "+v"(tid));
    const int wid = __builtin_amdgcn_readfirstlane(tid >> 6), lane = tid & 63, wr = wid >> 2, wc = wid & 3, fr = lane & 15, fq = lane >> 4;
    const int K = g.K, ntK = K / BK;
    unsigned voffA[2], voffB[2];
#pragma unroll
    for (int i = 0; i < 2; ++i) { int R, C; stage_rc(tid * 16 + i * 8192, R, C); const int Rb = Epi::PERM ? ((R & ~31) + perm32(R & 31)) : R;
        voffA[i] = (unsigned)(R * g.lda + C) * 2u; voffB[i] = (unsigned)(Rb * g.ldb + C) * 2u; }
    const size_t kstep = (size_t)(BK * 2);
    const size_t hstepA = (size_t)HALF * g.lda * 2, hstepB = (size_t)HALF * g.ldb * 2;
    const size_t tstepA = 2 * hstepA, tstepB = 2 * hstepB;
    const unsigned ldsw = (unsigned)wid * 1024u;
    const int aoff = lds_byte(wr * 64 + fr, fq * 8), boff = lds_byte(wc * 32 + fr, fq * 8);
#define PG8_SA(b, h) (((b) * 2 + (h)) * HTB)
#define PG8_SB(b, h) ((4 + (b) * 2 + (h)) * HTB)
#define PG8_STAGE(bufoff, gbase, voff) do { _Pragma("unroll") for (int _i = 0; _i < 2; ++_i) \
        __builtin_amdgcn_global_load_lds((const unsigned*)((const char*)(gbase) + (voff)[_i]), (LAS unsigned*)(lds + (bufoff) + ldsw + _i * 8192), 16, 0, 0); } while (0)
#define PG8_LDA(dst, b, h) do { _Pragma("unroll") for (int m = 0; m < 4; ++m) _Pragma("unroll") for (int k = 0; k < 2; ++k) dst[m][k] = *(const LAS bf16x8*)(lds + PG8_SA(b, h) + aoff + m * 2048 + k * 1024); } while (0)
#define PG8_LDB(dst, b, h) do { _Pragma("unroll") for (int n = 0; n < 2; ++n) _Pragma("unroll") for (int k = 0; k < 2; ++k) dst[n][k] = *(const LAS bf16x8*)(lds + PG8_SB(b, h) + boff + n * 2048 + k * 1024); } while (0)
#define PG8_MMA(ai, bj, At, Bt) do { __builtin_amdgcn_s_setprio(1); _Pragma("unroll") for (int m = 0; m < 4; ++m) _Pragma("unroll") for (int n = 0; n < 2; ++n) _Pragma("unroll") for (int k = 0; k < 2; ++k) \
        acc[ai][bj][m][n] = __builtin_amdgcn_mfma_f32_16x16x32_bf16(Bt[n][k], At[m][k], acc[ai][bj][m][n], 0, 0, 0); __builtin_amdgcn_s_setprio(0); } while (0)
#define PG8_WAIT_V(n) asm volatile("s_waitcnt vmcnt(" #n ")" ::: "memory")
#define PG8_WAIT_L(n) asm volatile("s_waitcnt lgkmcnt(" #n ")" ::: "memory")
#define PG8_BAR __builtin_amdgcn_s_barrier()
#define PG8_SCHED __builtin_amdgcn_sched_barrier(0)
    Unit cur, nxt; int ui = 0;
    if (!S.next(0, cur)) return;
    int nt = cur.nkt ? cur.nkt : ntK;
    f32x4 acc[2][2][4][2];
#pragma unroll
    for (int a = 0; a < 2; ++a)
#pragma unroll
        for (int b = 0; b < 2; ++b)
#pragma unroll
            for (int m = 0; m < 4; ++m)
#pragma unroll
                for (int n = 0; n < 2; ++n) acc[a][b][m][n] = (f32x4){0.f, 0.f, 0.f, 0.f};
    bf16x8 At[4][2], B0[2][2], B1[2][2];
    const char* cA = (const char*)g.A + (size_t)cur.pm * tstepA + (size_t)cur.kt0 * kstep; const char* cB = (const char*)g.Bt + (size_t)cur.pn * tstepB + (size_t)cur.kt0 * kstep;
    if constexpr (SP2) {
        PG8_STAGE(PG8_SB(0, 0), cB, voffB); PG8_STAGE(PG8_SB(0, 1), cB + hstepB, voffB); PG8_STAGE(PG8_SA(0, 0), cA, voffA); PG8_STAGE(PG8_SA(0, 1), cA + hstepA, voffA);
        if (wr == 1) PG8_BAR;
        PG8_WAIT_V(2); PG8_BAR;
        PG8_STAGE(PG8_SB(1, 0), cB + kstep, voffB); PG8_STAGE(PG8_SA(1, 0), cA + kstep, voffA); PG8_STAGE(PG8_SB(1, 1), cB + hstepB + kstep, voffB);
        PG8_WAIT_V(6); PG8_BAR;
    }
    for (;;) {
        const bool has_next = S.next(ui + 1, nxt);
        const char* nA = has_next ? (const char*)g.A + (size_t)nxt.pm * tstepA + (size_t)nxt.kt0 * kstep : cA; const char* nB = has_next ? (const char*)g.Bt + (size_t)nxt.pn * tstepB + (size_t)nxt.kt0 * kstep : cB;
        for (int t = 0; t < nt; t += 2) {
            const bool last = (t == nt - 2);
            const char* a1 = cA + (size_t)(t + 1) * kstep;
            const char* a2 = last ? nA : cA + (size_t)(t + 2) * kstep; const char* b2 = last ? nB : cB + (size_t)(t + 2) * kstep;
            const char* a3 = a2 + kstep; const char* b3 = b2 + kstep;
            PG8_LDB(B0, 0, 0); PG8_LDB(B1, 0, 1); PG8_SCHED; PG8_LDA(At, 0, 0); PG8_STAGE(PG8_SA(1, 1), a1 + hstepA, voffA);
            PG8_WAIT_V(8); PG8_WAIT_L(0); PG8_BAR; PG8_MMA(0, 0, At, B0); PG8_MMA(0, 1, At, B1); PG8_BAR; PG8_SCHED;
            PG8_LDA(At, 0, 1); PG8_STAGE(PG8_SB(0, 0), b2, voffB); PG8_STAGE(PG8_SB(0, 1), b2 + hstepB, voffB); PG8_STAGE(PG8_SA(0, 0), a2, voffA);
            PG8_WAIT_V(8); PG8_WAIT_L(0); PG8_BAR; PG8_MMA(1, 0, At, B0); PG8_MMA(1, 1, At, B1); PG8_BAR; PG8_SCHED;
            PG8_LDB(B0, 1, 0); PG8_LDB(B1, 1, 1); PG8_SCHED; PG8_LDA(At, 1, 0); PG8_STAGE(PG8_SA(0, 1), a2 + hstepA, voffA);
            PG8_WAIT_V(8); PG8_WAIT_L(0); PG8_BAR; PG8_MMA(0, 0, At, B0); PG8_MMA(0, 1, At, B1); PG8_BAR; PG8_SCHED;
            PG8_LDA(At, 1, 1); PG8_STAGE(PG8_SB(1, 0), b3, voffB); PG8_STAGE(PG8_SB(1, 1), b3 + hstepB, voffB); PG8_STAGE(PG8_SA(1, 0), a3, voffA);
            PG8_WAIT_V(8); PG8_WAIT_L(0); PG8_BAR; PG8_MMA(1, 0, At, B0); PG8_MMA(1, 1, At, B1); PG8_BAR; PG8_SCHED;
        }
        if constexpr (ALIGN_EPI) { if (wr == 0) PG8_BAR; }
        E(acc, cur, wr, wc, fr, fq);
        if (!has_next) break;
#pragma unroll
        for (int a = 0; a < 2; ++a)
#pragma unroll
            for (int b = 0; b < 2; ++b)
#pragma unroll
                for (int m = 0; m < 4; ++m)
#pragma unroll
                    for (int n = 0; n < 2; ++n) acc[a][b][m][n] = (f32x4){0.f, 0.f, 0.f, 0.f};
        cur = nxt; cA = nA; cB = nB; ++ui; nt = cur.nkt ? cur.nkt : ntK;
        if constexpr (ALIGN_EPI) { if (wr == 1) PG8_BAR; }
    }
    PG8_WAIT_V(0);
    if constexpr (!ALIGN_EPI) { if (wr == 0) PG8_BAR; }
    PG8_BAR;
#undef PG8_SA
#undef PG8_SB
#undef PG8_STAGE
#undef PG8_LDA
#undef PG8_LDB
#undef PG8_MMA
#undef PG8_WAIT_V
#undef PG8_WAIT_L
#undef PG8_BAR
#undef PG8_SCHED
}

typedef f32x4 Acc[2][2][4][2];

struct EpiStore {
    static constexpr bool PERM = true;
    bf16_t* O; int ldc;
    __device__ __forceinline__ void operator()(Acc& acc, const Unit& u, int wr, int wc, int fr, int fq) const {
        const int row0 = u.pm * BM + wr * 64 + fr, col0 = u.pn * BM + wc * 32 + 8 * fq;
#pragma unroll
        for (int ai = 0; ai < 2; ++ai)
#pragma unroll
            for (int m = 0; m < 4; ++m) { bf16_t* rowp = O + (size_t)(row0 + ai * HALF + m * 16) * ldc + col0;
#pragma unroll
                for (int bj = 0; bj < 2; ++bj) { const f32x4 v0 = acc[ai][bj][m][0], v1 = acc[ai][bj][m][1];
                    u32x4 w; w.x = cvt_pk_bf16(v0[0], v0[1]); w.y = cvt_pk_bf16(v0[2], v0[3]); w.z = cvt_pk_bf16(v1[0], v1[1]); w.w = cvt_pk_bf16(v1[2], v1[3]);
                    *(u32x4*)(rowp + bj * HALF) = w; } }
    }
};

struct EpiQ0 {
    static constexpr bool PERM = true;
    bf16_t* Q; const float* RS;
    __device__ __forceinline__ void operator()(Acc& acc, const Unit& u, int wr, int wc, int fr, int fq) const {
        const int row0 = u.pm * BM + wr * 64 + fr, col0 = u.pn * BM + wc * 32 + 8 * fq;
#pragma unroll
        for (int ai = 0; ai < 2; ++ai)
#pragma unroll
            for (int m = 0; m < 4; ++m) { const int r = row0 + ai * HALF + m * 16; const float rq = RS[2 * r];
                bf16_t* drow = Q + (size_t)r * 768 + col0;
#pragma unroll
                for (int bj = 0; bj < 2; ++bj) {
                    const f32x4 v0 = acc[ai][bj][m][0] * rq, v1 = acc[ai][bj][m][1] * rq;
                    u32x4 w; w.x = cvt_pk_bf16(v0[0], v0[1]); w.y = cvt_pk_bf16(v0[2], v0[3]); w.z = cvt_pk_bf16(v1[0], v1[1]); w.w = cvt_pk_bf16(v1[2], v1[3]);
                    *(u32x4*)(drow + bj * HALF) = w; }
                if (m & 1) asm volatile("" ::: "memory"); }
    }
};

struct EpiKV0 {
    static constexpr bool PERM = true;
    bf16_t* Kb; bf16_t* Vb; const float* RS;
    __device__ __forceinline__ void operator()(Acc& acc, const Unit& u, int wr, int wc, int fr, int fq) const {
        const int row0 = u.pm * BM + wr * 64 + fr, col0 = u.pn * BM + wc * 32 + 8 * fq;
        const bool isK = (u.pn * BM) < 512;
        const int ld = isK ? 768 : 512;
        const int c1 = col0 + HALF;
        const int oA = isK ? ((col0 >> 6) * 96 + (col0 & 63)) : (col0 - 512);
        const int oB = isK ? ((c1 >> 6) * 96 + (c1 & 63)) : (c1 - 512);
        bf16_t* base = isK ? Kb : Vb;
        const float* rsp = RS + 2 * row0 + 1;
#pragma unroll
        for (int ai = 0; ai < 2; ++ai) {
            float rkv[4];
#pragma unroll
            for (int m = 0; m < 4; ++m) rkv[m] = rsp[2 * (ai * HALF + m * 16)];
#pragma unroll
            for (int m = 0; m < 4; ++m) { const int r = row0 + ai * HALF + m * 16; const float rk = rkv[m];
                bf16_t* drow = base + (size_t)r * ld;
#pragma unroll
                for (int bj = 0; bj < 2; ++bj) {
                    const f32x4 v0 = acc[ai][bj][m][0] * rk, v1 = acc[ai][bj][m][1] * rk;
                    u32x4 w; w.x = cvt_pk_bf16(v0[0], v0[1]); w.y = cvt_pk_bf16(v0[2], v0[3]); w.z = cvt_pk_bf16(v1[0], v1[1]); w.w = cvt_pk_bf16(v1[2], v1[3]);
                    *(u32x4*)(drow + (bj ? oB : oA)) = w; }
                asm volatile("" ::: "memory"); } }
    }
};

struct EpiResid {
    static constexpr bool PERM = false;
    const float* xin_lat; const float* xin_ctx; float* out; const float* mod; int gj;
    __device__ __forceinline__ void operator()(Acc& acc, const Unit& u, int wr, int wc, int fr, int fq) const {
        const int rb = u.pm * BM, row0 = rb + wr * 64 + fr, col0 = u.pn * BM + wc * 32 + 4 * fq;
        const int v = rb < RL ? (rb >> 13) : 4;
        const float* gate = mod + (size_t)(v * 6 + gj) * DM;
        const float* src = rb < RL ? xin_lat + (size_t)row0 * DM : xin_ctx + (size_t)(row0 - RL) * DM;
        float* dst = out + (size_t)row0 * DM;
        f32x4 gv[2][2];
#pragma unroll
        for (int bj = 0; bj < 2; ++bj)
#pragma unroll
            for (int n = 0; n < 2; ++n) gv[bj][n] = *(const f32x4*)(gate + col0 + bj * HALF + n * 16);
#pragma unroll
        for (int ai = 0; ai < 2; ++ai)
#pragma unroll
            for (int m = 0; m < 4; ++m) { const size_t ro = (size_t)(ai * HALF + m * 16) * DM;
#pragma unroll
                for (int bj = 0; bj < 2; ++bj)
#pragma unroll
                    for (int n = 0; n < 2; ++n) { const int off = col0 + bj * HALF + n * 16;
                        const f32x4 xs = *(const f32x4*)(src + ro + off);
                        *(f32x4*)(dst + ro + off) = xs + gv[bj][n] * acc[ai][bj][m][n]; }
                asm volatile("" ::: "memory"); }
    }
};

struct EpiResidMod {
    static constexpr bool PERM = false;
    const float* xin_lat; const float* xin_ctx; const bf16_t* xsrc16; bf16_t* xout16; const float* mod; int gj;
    const float* modn; int sj; bf16_t* H; const float* gfin; float* fout;
    unsigned* xbuf; unsigned* cnt; unsigned want; LAS unsigned char* l; float* slab; unsigned* scnt; unsigned swant;
    __device__ __forceinline__ void operator()(Acc& acc, const Unit& u, int wr, int wc, int fr, int fq) const {
        const int rb = u.pm * BM, row0 = rb + wr * 64 + fr, col0 = u.pn * BM + wc * 32 + 4 * fq;
        const int v = rb < RL ? (rb >> 13) : 4;
        const int wid = wr * 4 + wc, lane = fq * 16 + fr;
        if (u.kh >= 0) {
            const int sidx = (u.pm - RL / BM) * 4 + u.pn;
            f32x4* sl = (f32x4*)(slab + (size_t)sidx * 65536) + (wid * 64 + lane);
            if (u.kh == 1) {
#pragma unroll
                for (int ai = 0; ai < 2; ++ai)
#pragma unroll
                    for (int bj = 0; bj < 2; ++bj)
#pragma unroll
                        for (int m = 0; m < 4; ++m)
#pragma unroll
                            for (int n = 0; n < 2; ++n) { *sl = acc[ai][bj][m][n]; sl += 512; asm volatile("" : "+v"(sl) :: "memory"); }
                asm volatile("s_waitcnt vmcnt(0)" ::: "memory"); __builtin_amdgcn_s_barrier(); asm volatile("" ::: "memory");
                if (wid == 0 && lane == 0) { __builtin_amdgcn_fence(__ATOMIC_RELEASE, "agent"); asm volatile("s_waitcnt vmcnt(0)" ::: "memory");
                    __hip_atomic_fetch_add(scnt + 64 * sidx, 1u, __ATOMIC_RELAXED, __HIP_MEMORY_SCOPE_AGENT); }
                return;
            }
            if (wid == 0) { unsigned sp = 0u;
                while ((unsigned)__builtin_amdgcn_readfirstlane(__hip_atomic_load(scnt + 64 * sidx, __ATOMIC_RELAXED, __HIP_MEMORY_SCOPE_AGENT)) < swant) { __builtin_amdgcn_s_sleep(2); if (++sp > (1u << 22)) break; } }
            asm volatile("s_waitcnt vmcnt(0) lgkmcnt(0)" ::: "memory"); __builtin_amdgcn_s_barrier(); asm volatile("" ::: "memory");
            __builtin_amdgcn_fence(__ATOMIC_ACQUIRE, "agent");
        }
        const bool addp = (u.kh == 0);
        const f32x4* slp = (const f32x4*)(slab + (size_t)((u.pm - RL / BM) * 4 + u.pn) * 65536) + (wid * 64 + lane);
        LAS float* P = (LAS float*)l; LAS float* S = (LAS float*)(l + 4096);
        {
            const float* gate = mod + (size_t)(v * 6 + gj) * DM;
            const float* src = rb < RL ? xin_lat + (size_t)row0 * DM : xin_ctx + (size_t)(row0 - RL) * DM;
            const bf16_t* s16 = xsrc16 + (size_t)row0 * DM;
            f32x4 gv[2][2];
#pragma unroll
            for (int bj = 0; bj < 2; ++bj)
#pragma unroll
                for (int n = 0; n < 2; ++n) gv[bj][n] = *(const f32x4*)(gate + col0 + bj * HALF + n * 16);
#pragma unroll
            for (int ai = 0; ai < 2; ++ai) {
                u32x2 xw[4][2][2];
                if (xsrc16) {
#pragma unroll
                    for (int m = 0; m < 4; ++m)
#pragma unroll
                        for (int bj = 0; bj < 2; ++bj)
#pragma unroll
                            for (int n = 0; n < 2; ++n) xw[m][bj][n] = *(const u32x2*)(s16 + (size_t)(ai * HALF + m * 16) * DM + col0 + bj * HALF + n * 16);
                }
#pragma unroll
                for (int m = 0; m < 4; ++m) { const size_t ro = (size_t)(ai * HALF + m * 16) * DM; float sq = 0.f;
#pragma unroll
                    for (int bj = 0; bj < 2; ++bj)
#pragma unroll
                        for (int n = 0; n < 2; ++n) { const int off = col0 + bj * HALF + n * 16;
                            f32x4 av = acc[ai][bj][m][n]; if (addp) av += slp[(size_t)(((ai * 2 + bj) * 4 + m) * 2 + n) * 512];
                            f32x4 xs;
                            if (xsrc16) { const u32x2 w2 = xw[m][bj][n]; xs[0] = bf_lo(w2.x); xs[1] = bf_hi(w2.x); xs[2] = bf_lo(w2.y); xs[3] = bf_hi(w2.y); }
                            else xs = *(const f32x4*)(src + ro + off);
                            const f32x4 o = xs + gv[bj][n] * av;
                            acc[ai][bj][m][n] = o; sq += (o[0] * o[0] + o[1] * o[1]) + (o[2] * o[2] + o[3] * o[3]);
                            if (xout16) { u32x2 wo; wo.x = cvt_pk_bf16(o[0], o[1]); wo.y = cvt_pk_bf16(o[2], o[3]); *(u32x2*)(xout16 + (size_t)row0 * DM + ro + off) = wo; } }
                    sq += __shfl_xor(sq, 16); sq += __shfl_xor(sq, 32);
                    if (fq == 0) P[(ai * HALF + wr * 64 + m * 16 + fr) * 4 + wc] = sq;
                    asm volatile("" ::: "memory"); } }
        }
        asm volatile("s_waitcnt lgkmcnt(0)" ::: "memory"); __builtin_amdgcn_s_barrier(); asm volatile("" ::: "memory");
        const int prow = wid * 32 + (lane & 31);
        if (lane < 32) { const f32x4 p4 = *(const LAS f32x4*)(P + prow * 4); const float t = (p4[0] + p4[1]) + (p4[2] + p4[3]);
            __hip_atomic_store(xbuf + (size_t)(rb + prow) * 4 + u.pn, __float_as_uint(t), __ATOMIC_RELAXED, __HIP_MEMORY_SCOPE_AGENT); }
        asm volatile("s_waitcnt vmcnt(0)" ::: "memory");
        if (lane == 0) __hip_atomic_fetch_add(cnt + 64 * u.pm, 1u, __ATOMIC_RELAXED, __HIP_MEMORY_SCOPE_AGENT);
        if (wid == 0) {
            unsigned sp = 0u;
            while ((unsigned)__builtin_amdgcn_readfirstlane(__hip_atomic_load(cnt + 64 * u.pm, __ATOMIC_RELAXED, __HIP_MEMORY_SCOPE_AGENT)) < want) {
                __builtin_amdgcn_s_sleep(2); if (++sp > (1u << 22)) break; }
            __builtin_amdgcn_fence(__ATOMIC_ACQUIRE, "agent");
        }
        asm volatile("s_waitcnt vmcnt(0) lgkmcnt(0)" ::: "memory"); __builtin_amdgcn_s_barrier(); asm volatile("" ::: "memory");
        if (lane < 32) { const unsigned* sl = xbuf + (size_t)(rb + prow) * 4; float t = 0.f;
#pragma unroll
            for (int c = 0; c < 4; ++c) t += __uint_as_float(__hip_atomic_load(sl + c, __ATOMIC_RELAXED, __HIP_MEMORY_SCOPE_AGENT));
            S[prow] = rsqrtf(t * (1.f / DM) + EPSN); }
        asm volatile("s_waitcnt lgkmcnt(0)" ::: "memory"); __builtin_amdgcn_s_barrier(); asm volatile("" ::: "memory");
        if (gfin) {
            f32x4 gf[2][2];
#pragma unroll
            for (int bj = 0; bj < 2; ++bj)
#pragma unroll
                for (int n = 0; n < 2; ++n) gf[bj][n] = *(const f32x4*)(gfin + col0 + bj * HALF + n * 16);
#pragma unroll
            for (int ai = 0; ai < 2; ++ai)
#pragma unroll
                for (int m = 0; m < 4; ++m) { const int rr = ai * HALF + wr * 64 + m * 16 + fr; const float rs = S[rr]; float* orow = fout + (size_t)(rb + rr) * DM + col0;
#pragma unroll
                    for (int bj = 0; bj < 2; ++bj)
#pragma unroll
                        for (int n = 0; n < 2; ++n) *(f32x4*)(orow + bj * HALF + n * 16) = acc[ai][bj][m][n] * rs * gf[bj][n]; }
        } else {
            const float* shp = modn + (size_t)(v * 6 + sj) * DM; const float* scp = shp + DM;
            f32x4 sh[2][2], sc[2][2];
#pragma unroll
            for (int bj = 0; bj < 2; ++bj)
#pragma unroll
                for (int n = 0; n < 2; ++n) { sh[bj][n] = *(const f32x4*)(shp + col0 + bj * HALF + n * 16); sc[bj][n] = *(const f32x4*)(scp + col0 + bj * HALF + n * 16) + 1.0f; }
#pragma unroll
            for (int ai = 0; ai < 2; ++ai)
#pragma unroll
                for (int m = 0; m < 4; ++m) { const int rr = ai * HALF + wr * 64 + m * 16 + fr; const float rs = S[rr]; bf16_t* hrow = H + (size_t)(rb + rr) * DM + col0;
#pragma unroll
                    for (int bj = 0; bj < 2; ++bj)
#pragma unroll
                        for (int n = 0; n < 2; ++n) { const f32x4 y = acc[ai][bj][m][n] * rs * sc[bj][n] + sh[bj][n];
                            u32x2 w; w.x = cvt_pk_bf16(y[0], y[1]); w.y = cvt_pk_bf16(y[2], y[3]); *(u32x2*)(hrow + bj * HALF + n * 16) = w; } }
        }
    }
};

struct EpiQKNorm {
    static constexpr bool PERM = true;
    bf16_t* O; const float* gq; const float* gk; const float2* ropec; LAS unsigned char* l;
    __device__ __forceinline__ void operator()(Acc& acc, const Unit& u, int wr, int wc, int fr, int fq) const {
        const int rb = u.pm * BM, row0 = rb + wr * 64 + fr, col0 = u.pn * BM + wc * 32 + 8 * fq;
        if (u.pn < 5) {
            const int wid = wr * 4 + wc, lane = fq * 16 + fr; const bool lat = rb < RL;
            LAS float* P = (LAS float*)l; LAS float* S = (LAS float*)(l + 8192);
#pragma unroll
            for (int ai = 0; ai < 2; ++ai)
#pragma unroll
                for (int m = 0; m < 4; ++m)
#pragma unroll
                    for (int bj = 0; bj < 2; ++bj) { const f32x4 a = acc[ai][bj][m][0], b = acc[ai][bj][m][1];
                        float sq = ((a[0] * a[0] + a[1] * a[1]) + (a[2] * a[2] + a[3] * a[3])) + ((b[0] * b[0] + b[1] * b[1]) + (b[2] * b[2] + b[3] * b[3]));
                        sq += __shfl_xor(sq, 16); sq += __shfl_xor(sq, 32);
                        if (fq == 0) P[((ai * HALF + wr * 64 + m * 16 + fr) * 2 + bj) * 4 + wc] = sq; }
            asm volatile("s_waitcnt lgkmcnt(0)" ::: "memory"); __builtin_amdgcn_s_barrier(); asm volatile("" ::: "memory");
            { const int t = wid * 64 + lane; const f32x4 p4 = *(const LAS f32x4*)(P + t * 4); S[t] = rsqrtf(((p4[0] + p4[1]) + (p4[2] + p4[3])) * (1.f / 128.f) + EPSN); }
            asm volatile("s_waitcnt lgkmcnt(0)" ::: "memory"); __builtin_amdgcn_s_barrier(); asm volatile("" ::: "memory");
            const float* gg = (u.pn < 4 ? gq : gk) + wc * 32 + 8 * fq;
            const f32x4 g0 = *(const f32x4*)gg, g1 = *(const f32x4*)(gg + 4);
#pragma unroll
            for (int ai = 0; ai < 2; ++ai) {
                f32x4 c0v[4], c1v[4];
#pragma unroll
                for (int m = 0; m < 4; ++m) { c0v[m] = (f32x4){1.f, 0.f, 1.f, 0.f}; c1v[m] = c0v[m];
                    if (lat) { const f32x4* cp = (const f32x4*)(ropec + (size_t)((rb + ai * HALF + wr * 64 + m * 16 + fr) & (NSEQ - 1)) * 64 + wc * 16 + 4 * fq); c0v[m] = cp[0]; c1v[m] = cp[1]; } }
#pragma unroll
                for (int m = 0; m < 4; ++m) { const int rr = ai * HALF + wr * 64 + m * 16 + fr, r = rb + rr;
                    const f32x4 c0 = c0v[m], c1 = c1v[m];
                    bf16_t* orow = O + (size_t)r * 1536 + col0;
#pragma unroll
                    for (int bj = 0; bj < 2; ++bj) { const float rn = S[rr * 2 + bj];
                        const f32x4 y0 = acc[ai][bj][m][0] * rn * g0, y1 = acc[ai][bj][m][1] * rn * g1;
                        u32x4 w;
                        w.x = cvt_pk_bf16(y0[0] * c0[0] - y0[1] * c0[1], y0[0] * c0[1] + y0[1] * c0[0]);
                        w.y = cvt_pk_bf16(y0[2] * c0[2] - y0[3] * c0[3], y0[2] * c0[3] + y0[3] * c0[2]);
                        w.z = cvt_pk_bf16(y1[0] * c1[0] - y1[1] * c1[1], y1[0] * c1[1] + y1[1] * c1[0]);
                        w.w = cvt_pk_bf16(y1[2] * c1[2] - y1[3] * c1[3], y1[2] * c1[3] + y1[3] * c1[2]);
                        *(u32x4*)(orow + bj * HALF) = w; }
                    asm volatile("" ::: "memory"); } }
        } else {
#pragma unroll
            for (int ai = 0; ai < 2; ++ai)
#pragma unroll
                for (int m = 0; m < 4; ++m) { bf16_t* rowp = O + (size_t)(row0 + ai * HALF + m * 16) * 1536 + col0;
#pragma unroll
                    for (int bj = 0; bj < 2; ++bj) { const f32x4 v0 = acc[ai][bj][m][0], v1 = acc[ai][bj][m][1];
                        u32x4 w; w.x = cvt_pk_bf16(v0[0], v0[1]); w.y = cvt_pk_bf16(v0[2], v0[3]); w.z = cvt_pk_bf16(v1[0], v1[1]); w.w = cvt_pk_bf16(v1[2], v1[3]);
                        *(u32x4*)(rowp + bj * HALF) = w; } }
        }
    }
};

template <int CTRL> __device__ __forceinline__ float dpp0(float v) { return __builtin_bit_cast(float, __builtin_amdgcn_update_dpp(0, __builtin_bit_cast(int, v), CTRL, 0xf, 0xf, true)); }
struct EpiFFN {
    static constexpr bool PERM = true;
    bf16_t* ACT; float* HALO; const float* cw; const float* cb;
    __device__ __forceinline__ void operator()(Acc& acc, const Unit& u, int wr, int wc, int fr, int fq) const {
        const int ch0 = u.pn * 128 + wc * 32 + 8 * fq;
        const bool e0 = (fr == 0), e15 = (fr == 15);
#pragma unroll
        for (int n = 0; n < 2; ++n) {
            const int ch = ch0 + 4 * n;
            const f32x4 w0 = *(const f32x4*)(cw + ch), w1 = *(const f32x4*)(cw + DFF + ch), w2 = *(const f32x4*)(cw + 2 * DFF + ch), bb = *(const f32x4*)(cb + ch);
#pragma unroll
            for (int ai = 0; ai < 2; ++ai) {
                const int q = 4 * u.pm + 2 * ai + wr;
                float* hp0 = HALO + (size_t)q * DFF + ch;
                if (e0) { *(f32x4*)(hp0 + HSZ) = acc[ai][0][0][n]; *(f32x4*)(hp0 + 2 * HSZ) = acc[ai][1][0][n]; }
                if (e15) { *(f32x4*)(hp0 + 4 * HSZ) = acc[ai][0][3][n]; *(f32x4*)(hp0 + 5 * HSZ) = acc[ai][1][3][n]; }
                f32x4 pre[4];
#pragma unroll
                for (int m = 0; m < 4; ++m) {
#pragma unroll
                    for (int e = 0; e < 4; ++e) {
                        const float g = acc[ai][0][m][n][e];
                        float pv;
                        if (m == 0)
                            asm volatile("v_mov_b32 %0, %1\n\tv_fmac_f32_dpp %0, %2, %3 row_shr:1 row_mask:0xf bank_mask:0xf bound_ctrl:1\n\tv_fmac_f32 %0, %2, %4\n\t"
                                         "v_fmac_f32_dpp %0, %2, %5 row_shl:1 row_mask:0xf bank_mask:0xf bound_ctrl:1\n\tv_fmac_f32_dpp %0, %6, %5 row_shr:15 row_mask:0xf bank_mask:0xf bound_ctrl:1"
                                         : "=&v"(pv) : "v"(bb[e]), "v"(g), "v"(w0[e]), "v"(w1[e]), "v"(w2[e]), "v"(acc[ai][0][1][n][e]));
                        else if (m == 3)
                            asm volatile("v_mov_b32 %0, %1\n\tv_fmac_f32_dpp %0, %2, %3 row_shr:1 row_mask:0xf bank_mask:0xf bound_ctrl:1\n\tv_fmac_f32 %0, %2, %4\n\t"
                                         "v_fmac_f32_dpp %0, %2, %5 row_shl:1 row_mask:0xf bank_mask:0xf bound_ctrl:1\n\tv_fmac_f32_dpp %0, %6, %3 row_shl:15 row_mask:0xf bank_mask:0xf bound_ctrl:1"
                                         : "=&v"(pv) : "v"(bb[e]), "v"(g), "v"(w0[e]), "v"(w1[e]), "v"(w2[e]), "v"(acc[ai][0][2][n][e]));
                        else
                            asm volatile("v_mov_b32 %0, %1\n\tv_fmac_f32_dpp %0, %2, %3 row_shr:1 row_mask:0xf bank_mask:0xf bound_ctrl:1\n\tv_fmac_f32 %0, %2, %4\n\t"
                                         "v_fmac_f32_dpp %0, %2, %5 row_shl:1 row_mask:0xf bank_mask:0xf bound_ctrl:1\n\tv_fmac_f32_dpp %0, %6, %3 row_shl:15 row_mask:0xf bank_mask:0xf bound_ctrl:1\n\t"
                                         "v_fmac_f32_dpp %0, %7, %5 row_shr:15 row_mask:0xf bank_mask:0xf bound_ctrl:1"
                                         : "=&v"(pv) : "v"(bb[e]), "v"(g), "v"(w0[e]), "v"(w1[e]), "v"(w2[e]), "v"(acc[ai][0][m - 1][n][e]), "v"(acc[ai][0][m + 1][n][e]));
                        pre[m][e] = pv;
                    }
                }
                if (e0) *(f32x4*)(hp0) = pre[0];
                if (e15) *(f32x4*)(hp0 + 3 * HSZ) = pre[3];
#pragma unroll
                for (int m = 0; m < 4; ++m)
#pragma unroll
                    for (int e = 0; e < 4; ++e) acc[ai][0][m][n][e] = silu_f(pre[m][e]) * acc[ai][1][m][n][e];
                __builtin_amdgcn_sched_barrier(0);
            }
        }
#pragma unroll
        for (int ai = 0; ai < 2; ++ai)
#pragma unroll
            for (int m = 0; m < 4; ++m) { const int r = u.pm * BM + ai * HALF + wr * 64 + m * 16 + fr; const f32x4 v0 = acc[ai][0][m][0], v1 = acc[ai][0][m][1];
                u32x4 w; w.x = cvt_pk_bf16(v0[0], v0[1]); w.y = cvt_pk_bf16(v0[2], v0[3]); w.z = cvt_pk_bf16(v1[0], v1[1]); w.w = cvt_pk_bf16(v1[2], v1[3]);
                *(u32x4*)(ACT + (size_t)r * DFF + ch0) = w; }
    }
};
}

namespace att {
constexpr int NW = 8, QBLK = 32, KVBLK = 64;
constexpr size_t SHM_V = KVBLK * 128 * 2, SHM_K = KVBLK * 128 * 2, SHM_ATTN = 2 * SHM_V + 2 * SHM_K + NW * 64 * 4;
#define KSWZ(row, colB) ((row) * 256 + ((colB) ^ (((row) & 7) << 4)))
#define SBAR() __builtin_amdgcn_sched_barrier(0)
__device__ __forceinline__ int crow(int r, int hi) { return (r & 3) + 8 * (r >> 2) + 4 * hi; }
__device__ __forceinline__ unsigned cvtpk(float lo, float hi) { unsigned r; asm volatile("v_cvt_pk_bf16_f32 %0, %1, %2" : "=v"(r) : "v"(lo), "v"(hi)); return r; }

__device__ __forceinline__ void partialSM(f32x16& p0, f32x16& p1, float& m_reg, float& mn, float& alpha, const float C, const float thr_raw) {
    float pmax = p0[0];
#pragma unroll
    for (int r = 1; r < 16; ++r) pmax = fmaxf(pmax, p0[r]);
#pragma unroll
    for (int r = 0; r < 16; ++r) pmax = fmaxf(pmax, p1[r]);
    { auto rr = __builtin_amdgcn_permlane32_swap(__float_as_uint(pmax), __float_as_uint(pmax), false, false);
      pmax = fmaxf(__uint_as_float(rr[0]), __uint_as_float(rr[1])); }
    if (__builtin_expect(__all(pmax - m_reg <= thr_raw), 1)) { mn = m_reg; alpha = 1.f; }
    else { mn = fmaxf(m_reg, pmax); alpha = __builtin_amdgcn_exp2f((m_reg - mn) * C); m_reg = mn; }
    const float mnC = -mn * C;
#pragma unroll
    for (int r = 0; r < 16; ++r) p0[r] = fmaf(p0[r], C, mnC);
#pragma unroll
    for (int r = 0; r < 16; ++r) p1[r] = fmaf(p1[r], C, mnC);
#pragma unroll
    for (int r = 0; r < 16; ++r) p0[r] = __builtin_amdgcn_exp2f(p0[r]);
}
__device__ __forceinline__ void finishSM(f32x16& p0, f32x16& p1, float alpha, float& l_reg, bf16x8& pa0, bf16x8& pa1, bf16x8& pa2, bf16x8& pa3) {
#pragma unroll
    for (int r = 0; r < 16; ++r) p1[r] = __builtin_amdgcn_exp2f(p1[r]);
    float ps = 0;
#pragma unroll
    for (int r = 0; r < 16; ++r) ps += p0[r];
#pragma unroll
    for (int r = 0; r < 16; ++r) ps += p1[r];
    { auto rr = __builtin_amdgcn_permlane32_swap(__float_as_uint(ps), __float_as_uint(ps), false, false);
      ps = __uint_as_float(rr[0]) + __uint_as_float(rr[1]); }
    l_reg = l_reg * alpha + ps;
#define PK4(P, BASE, OUT) do { unsigned a0 = cvtpk(P[BASE + 0], P[BASE + 1]), a1 = cvtpk(P[BASE + 2], P[BASE + 3]);   \
    unsigned b0 = cvtpk(P[BASE + 4], P[BASE + 5]), b1 = cvtpk(P[BASE + 6], P[BASE + 7]);                              \
    auto r0 = __builtin_amdgcn_permlane32_swap(a0, b0, false, false); auto r1 = __builtin_amdgcn_permlane32_swap(a1, b1, false, false); \
    u32x4 w = {r0[0], r1[0], r0[1], r1[1]}; OUT = *reinterpret_cast<bf16x8*>(&w); } while (0)
    PK4(p0, 0, pa0); PK4(p0, 8, pa1); PK4(p1, 0, pa2); PK4(p1, 8, pa3);
#undef PK4
}
template <int NDQ>
__device__ __forceinline__ void qkt(f32x16& p0, f32x16& p1, const char* Ks, const bf16x8* qr, int r32, int hi) {
    p0 = f32x16{}; p1 = f32x16{};
#pragma unroll
    for (int d0 = 0; d0 < NDQ; ++d0) { const int cb = (d0 * 16 + hi * 8) * 2;
        const bf16x8 b0 = *reinterpret_cast<const bf16x8*>(Ks + KSWZ(r32, cb));
        const bf16x8 b1 = *reinterpret_cast<const bf16x8*>(Ks + KSWZ(32 + r32, cb));
        p0 = __builtin_amdgcn_mfma_f32_32x32x16_bf16(b0, qr[d0], p0, 0, 0, 0);
        p1 = __builtin_amdgcn_mfma_f32_32x32x16_bf16(b1, qr[d0], p1, 0, 0, 0); }
}
__device__ __forceinline__ int v_st(int k, int c) { const int kk = (k & ~0xC) | ((k & 4) << 1) | ((k & 8) >> 1); return ((kk >> 3) * 4 + (c >> 5)) * 512 + ((kk & 7) * 32 + (c & 31)) * 2; }
__device__ __forceinline__ int v_rd_base(int lane) { return ((lane & 3) << 3) | (((lane >> 2) & 3) << 6) | (((lane >> 4) & 1) << 5) | (((lane >> 5) & 1) << 8); }
constexpr int v_rd_off(int d0, int ks, int half) { return d0 * 512 + ks * 4096 + half * 2048; }
template <int OFF> __device__ __forceinline__ s16x4 tr_read(int vb) {
    s16x4 r; asm volatile("ds_read_b64_tr_b16 %0, %1 offset:%2" : "=&v"(r) : "v"(vb), "i"(OFF) : "memory"); return r;
}
template <int D0> __device__ __forceinline__ void pv_one(f32x16& od, int vb, bf16x8 pa0, bf16x8 pa1, bf16x8 pa2, bf16x8 pa3) {
    const s16x4 l0 = tr_read<v_rd_off(D0, 0, 0)>(vb), h0 = tr_read<v_rd_off(D0, 0, 1)>(vb), l1 = tr_read<v_rd_off(D0, 1, 0)>(vb), h1 = tr_read<v_rd_off(D0, 1, 1)>(vb);
    const s16x4 l2 = tr_read<v_rd_off(D0, 2, 0)>(vb), h2 = tr_read<v_rd_off(D0, 2, 1)>(vb), l3 = tr_read<v_rd_off(D0, 3, 0)>(vb), h3 = tr_read<v_rd_off(D0, 3, 1)>(vb);
    asm volatile("s_waitcnt lgkmcnt(0)" ::: "memory"); SBAR();
#define PK(L, H) (bf16x8){L[0], L[1], L[2], L[3], H[0], H[1], H[2], H[3]}
    od = __builtin_amdgcn_mfma_f32_32x32x16_bf16(pa0, PK(l0, h0), od, 0, 0, 0);
    od = __builtin_amdgcn_mfma_f32_32x32x16_bf16(pa1, PK(l1, h1), od, 0, 0, 0);
    od = __builtin_amdgcn_mfma_f32_32x32x16_bf16(pa2, PK(l2, h2), od, 0, 0, 0);
    od = __builtin_amdgcn_mfma_f32_32x32x16_bf16(pa3, PK(l3, h3), od, 0, 0, 0);
#undef PK
}
template <int NDV> __device__ __forceinline__ void pv_d0(f32x16* o, int vb, bf16x8 pa0, bf16x8 pa1, bf16x8 pa2, bf16x8 pa3) {
    pv_one<0>(o[0], vb, pa0, pa1, pa2, pa3); pv_one<1>(o[1], vb, pa0, pa1, pa2, pa3);
    if constexpr (NDV == 4) { pv_one<2>(o[2], vb, pa0, pa1, pa2, pa3); pv_one<3>(o[3], vb, pa0, pa1, pa2, pa3); }
}

template <int NDQ, int NDV>
__device__ __forceinline__ void attn_unit(const bf16_t* __restrict__ Qb, const int ldq,
                                          const bf16_t* __restrict__ Kc, const bf16_t* __restrict__ Kl, const int ldk,
                                          const bf16_t* __restrict__ Vc, const bf16_t* __restrict__ Vl, const int ldv,
                                          bf16_t* __restrict__ Ob, const int ldo, const int nkeys, const int nctx,
                                          const float C, const float thr_raw, char* lds, const float2* ropeq = nullptr, const int tq0 = 0) {
    constexpr int SDEPTH = 2;
    constexpr int WK = NDQ * 16, WV = NDV * 32;
    int tid = threadIdx.x; asm volatile("" : "+v"(tid));
    const int wid = tid >> 6, lane = tid & 63, r32 = lane & 31, hi = lane >> 5;
    char* V_lds = lds; char* K_lds = lds + 2 * SHM_V;
    float* ws = (float*)(lds + 2 * SHM_V + 2 * SHM_K) + wid * 64; float* li_l = ws; float* al_l = ws + 32;
    float m_reg = -1e30f, l_reg = 0; f32x16 o[NDV] = {}; bf16x8 qr[NDQ];
    const bf16_t* Qw = Qb + (long)(wid * QBLK + r32) * ldq + hi * 8;
#pragma unroll
    for (int d0 = 0; d0 < NDQ; ++d0) qr[d0] = *reinterpret_cast<const bf16x8*>(Qw + d0 * 16);
    if constexpr (NDQ == 6) {
        if (ropeq) {
            const f32x4* cp = (const f32x4*)(ropeq + (size_t)(tq0 + wid * QBLK + r32) * 16 + hi * 4);
#pragma unroll
            for (int dd = 0; dd < 2; ++dd) { const f32x4 c0 = cp[dd * 4], c1 = cp[dd * 4 + 1]; const bf16x8 q = qr[4 + dd];
                float x[8];
#pragma unroll
                for (int j = 0; j < 8; ++j) x[j] = __uint_as_float(((unsigned)(unsigned short)q[j]) << 16);
                u32x4 w;
                w.x = cvtpk(x[0] * c0[0] - x[1] * c0[1], x[0] * c0[1] + x[1] * c0[0]);
                w.y = cvtpk(x[2] * c0[2] - x[3] * c0[3], x[2] * c0[3] + x[3] * c0[2]);
                w.z = cvtpk(x[4] * c1[0] - x[5] * c1[1], x[4] * c1[1] + x[5] * c1[0]);
                w.w = cvtpk(x[6] * c1[2] - x[7] * c1[3], x[6] * c1[3] + x[7] * c1[2]);
                qr[4 + dd] = *reinterpret_cast<bf16x8*>(&w); }
        }
    }
    const int sr = tid >> 4, sc = (tid & 15) * 8, vst0 = v_st(sr, sc), vst1 = v_st(32 + sr, sc);
    const int scK = sc < WK ? sc : sc - (128 - WK), scV = sc < WV ? sc : sc - (128 - WV);
    const int vb0 = (int)(uintptr_t)V_lds + v_rd_base(lane);
    struct { bf16x8 vs0, vs1, ks0, ks1; } sr_[SDEPTH];
    constexpr bool MLA = (NDQ == 6 && NDV == 2);
    const int mvr = tid >> 3, mvc = (tid & 7) * 8, mk0r = tid / 12, mk0c = (tid - mk0r * 12) * 8, mk1r = (tid + 512) / 12, mk1c = ((tid + 512) - mk1r * 12) * 8;
    const int mvst = v_st(mvr, mvc); const bool mk1 = tid < 256;
#define SLOAD(i, k0) do { const int k0_ = (k0); const bf16_t* kp_ = k0_ < nctx ? Kc + (long)k0_ * ldk : Kl + (long)(k0_ - nctx) * ldk; \
    const bf16_t* vp_ = k0_ < nctx ? Vc + (long)k0_ * ldv : Vl + (long)(k0_ - nctx) * ldv; \
    if constexpr (MLA) { \
      sr_[i].vs0 = *reinterpret_cast<const bf16x8*>(vp_ + (long)mvr * ldv + mvc); \
      sr_[i].ks0 = *reinterpret_cast<const bf16x8*>(kp_ + (long)mk0r * ldk + mk0c); \
      if (mk1) sr_[i].ks1 = *reinterpret_cast<const bf16x8*>(kp_ + (long)mk1r * ldk + mk1c); \
    } else { \
    sr_[i].vs0 = *reinterpret_cast<const bf16x8*>(vp_ + (long)sr * ldv + scV); sr_[i].vs1 = *reinterpret_cast<const bf16x8*>(vp_ + (long)(32 + sr) * ldv + scV); \
    sr_[i].ks0 = *reinterpret_cast<const bf16x8*>(kp_ + (long)sr * ldk + scK); sr_[i].ks1 = *reinterpret_cast<const bf16x8*>(kp_ + (long)(32 + sr) * ldk + scK); } } while (0)
#define SWRITE(b, i) do { if constexpr (MLA) { \
    *(bf16x8*)(V_lds + (b) * SHM_V + mvst) = sr_[i].vs0; \
    *(bf16x8*)(K_lds + (b) * SHM_K + KSWZ(mk0r, mk0c * 2)) = sr_[i].ks0; \
    if (mk1) *(bf16x8*)(K_lds + (b) * SHM_K + KSWZ(mk1r, mk1c * 2)) = sr_[i].ks1; \
    } else { *(bf16x8*)(V_lds + (b) * SHM_V + vst0) = sr_[i].vs0;          \
    *(bf16x8*)(V_lds + (b) * SHM_V + vst1) = sr_[i].vs1; const int kc = sc * 2;               \
    *(bf16x8*)(K_lds + (b) * SHM_K + KSWZ(sr, kc)) = sr_[i].ks0;                       \
    *(bf16x8*)(K_lds + (b) * SHM_K + KSWZ(32 + sr, kc)) = sr_[i].ks1; } } while (0)
#define SWAIT() do { if constexpr (MLA) asm volatile("s_waitcnt vmcnt(3)" ::: "memory"); else asm volatile("s_waitcnt vmcnt(4)" ::: "memory"); } while (0)
#define RESC(a) do { if (__any((a) < 1.f)) { if (hi == 0) al_l[r32] = (a); asm volatile("s_waitcnt lgkmcnt(0)" ::: "memory"); \
    _Pragma("unroll") for (int d = 0; d < NDV; ++d) _Pragma("unroll") for (int r = 0; r < 16; ++r) o[d][r] *= al_l[crow(r, hi)]; } } while (0)
    f32x16 pA0, pA1, pB0, pB1; float mnA, mnB, alA, alB; bf16x8 pa0, pa1, pa2, pa3; const int NT = nkeys / KVBLK;
    constexpr int SE = 0, SO = SDEPTH - 1;
    SLOAD(SE, 0); asm volatile("s_waitcnt vmcnt(0)" ::: "memory"); SWRITE(0, SE); __syncthreads();
    qkt<NDQ>(pA0, pA1, K_lds, qr, r32, hi); partialSM(pA0, pA1, m_reg, mnA, alA, C, thr_raw);
    SLOAD(SO, KVBLK); if (2 < NT) SLOAD(SE, 2 * KVBLK);
    SWAIT(); SWRITE(1, SO); __syncthreads();
    for (int j = 1; j + 1 < NT; j += 2) {
        SBAR(); qkt<NDQ>(pB0, pB1, K_lds + SHM_K, qr, r32, hi);
        finishSM(pA0, pA1, alA, l_reg, pa0, pa1, pa2, pa3); SBAR();
        SLOAD(SO, (j + SDEPTH) * KVBLK); SBAR();
        pv_d0<NDV>(o, vb0, pa0, pa1, pa2, pa3); partialSM(pB0, pB1, m_reg, mnB, alB, C, thr_raw);
        __syncthreads(); SWAIT(); SWRITE(0, SE);
        RESC(alB); __syncthreads();
        SBAR(); qkt<NDQ>(pA0, pA1, K_lds, qr, r32, hi);
        finishSM(pB0, pB1, alB, l_reg, pa0, pa1, pa2, pa3); SBAR();
        if (j + 3 < NT) SLOAD(SE, (j + 1 + SDEPTH) * KVBLK); SBAR();
        pv_d0<NDV>(o, vb0 + (int)SHM_V, pa0, pa1, pa2, pa3); partialSM(pA0, pA1, m_reg, mnA, alA, C, thr_raw);
        __syncthreads(); SWAIT(); SWRITE(1, SO);
        RESC(alA); __syncthreads();
    }
    SBAR(); qkt<NDQ>(pB0, pB1, K_lds + SHM_K, qr, r32, hi);
    finishSM(pA0, pA1, alA, l_reg, pa0, pa1, pa2, pa3); SBAR();
    pv_d0<NDV>(o, vb0, pa0, pa1, pa2, pa3); partialSM(pB0, pB1, m_reg, mnB, alB, C, thr_raw);
    __syncthreads(); RESC(alB);
    finishSM(pB0, pB1, alB, l_reg, pa0, pa1, pa2, pa3); SBAR();
    pv_d0<NDV>(o, vb0 + (int)SHM_V, pa0, pa1, pa2, pa3);
    if (hi == 0) li_l[r32] = l_reg; asm volatile("s_waitcnt lgkmcnt(0)" ::: "memory");
    float rli[16];
#pragma unroll
    for (int r = 0; r < 16; ++r) rli[r] = __builtin_amdgcn_rcpf(li_l[crow(r, hi)]);
    bf16_t* Ow = Ob + (long)(wid * QBLK) * ldo;
#pragma unroll
    for (int r = 0; r < 16; ++r) { const int orow = crow(r, hi);
#pragma unroll
        for (int d0 = 0; d0 < NDV; ++d0) Ow[(long)orow * ldo + d0 * 32 + r32] = (bf16_t)(cvtpk(o[d0][r] * rli[r], 0.f) & 0xffffu); }
    asm volatile("s_waitcnt vmcnt(0) lgkmcnt(0)" ::: "memory");
    __syncthreads();
#undef SLOAD
#undef SWRITE
#undef SWAIT
#undef RESC
}
}

__device__ __forceinline__ void modulate_2rows(const float* xrow0, const float* xrow1, const float* shift, const float* scale, bf16_t* orow0, bf16_t* orow1, int ln) {
    const f32x4* xa = (const f32x4*)xrow0 + ln; const f32x4* xb = (const f32x4*)xrow1 + ln;
    f32x4 va[4], vb[4]; float sa = 0.f, sb = 0.f;
#pragma unroll
    for (int j = 0; j < 4; ++j) { va[j] = __builtin_nontemporal_load(xa + 64 * j); vb[j] = __builtin_nontemporal_load(xb + 64 * j); }
#pragma unroll
    for (int j = 0; j < 4; ++j) { sa += (va[j][0] * va[j][0] + va[j][1] * va[j][1]) + (va[j][2] * va[j][2] + va[j][3] * va[j][3]);
                                  sb += (vb[j][0] * vb[j][0] + vb[j][1] * vb[j][1]) + (vb[j][2] * vb[j][2] + vb[j][3] * vb[j][3]); }
#pragma unroll
    for (int o = 1; o < 64; o <<= 1) { sa += __shfl_xor(sa, o); sb += __shfl_xor(sb, o); }
    const float ra = rsqrtf(sa * (1.f / DM) + EPSN), rb = rsqrtf(sb * (1.f / DM) + EPSN);
    u32x2* oa = (u32x2*)orow0 + ln; u32x2* ob = (u32x2*)orow1 + ln;
#pragma unroll
    for (int j = 0; j < 4; ++j) { const f32x4 sh = ((const f32x4*)shift)[ln + 64 * j], sc = ((const f32x4*)scale)[ln + 64 * j] + 1.0f;
        const f32x4 ya = va[j] * ra * sc + sh, yb = vb[j] * rb * sc + sh;
        u32x2 w; w.x = cvt_pk_bf16(ya[0], ya[1]); w.y = cvt_pk_bf16(ya[2], ya[3]); oa[64 * j] = w;
        w.x = cvt_pk_bf16(yb[0], yb[1]); w.y = cvt_pk_bf16(yb[2], yb[3]); ob[64 * j] = w; }
}

template <class F>
__device__ __forceinline__ void tr_item(F ld, bf16_t* WT, int ldt, int k0, int n0, LAS float* scr, int lane) {
#pragma unroll 8
    for (int i = 0; i < 32; ++i) { const int kk = 2 * i + (lane >> 5); scr[kk * 33 + (lane & 31)] = ld(k0 + kk, n0 + (lane & 31)); }
    asm volatile("s_waitcnt lgkmcnt(0)" ::: "memory");
    const int c = lane & 7;
#pragma unroll
    for (int j = 0; j < 4; ++j) { const int n = (lane >> 3) + 8 * j; const LAS float* s = scr + (8 * c) * 33 + n;
        u32x4 o; o.x = cvt_pk_bf16(s[0 * 33], s[1 * 33]); o.y = cvt_pk_bf16(s[2 * 33], s[3 * 33]); o.z = cvt_pk_bf16(s[4 * 33], s[5 * 33]); o.w = cvt_pk_bf16(s[6 * 33], s[7 * 33]);
        *(u32x4*)(WT + (size_t)(n0 + n) * ldt + k0 + 8 * c) = o; }
    asm volatile("s_waitcnt lgkmcnt(0)" ::: "memory");
}

__device__ __forceinline__ void fix_edges(bf16_t* __restrict__ ACTp, const float* __restrict__ HALOp, const float* __restrict__ cw, int q, int e, int ln) {
    const int row = 64 * q + (e ? 63 : 0);
    const bool lat = row < RL; const int tpos = lat ? (row & (NSEQ - 1)) : ((row - RL) & (NCTX - 1)); const int T = lat ? NSEQ : NCTX;
    const bool has = e ? (tpos != T - 1) : (tpos != 0);
    const float* HPp = HALOp + (e ? 3 : 0) * HSZ + (size_t)q * DFF; const float* HUp = HALOp + (e ? 5 : 2) * HSZ + (size_t)q * DFF;
    const float* HGn = e ? HALOp + 1 * HSZ + (size_t)(q + 1) * DFF : HALOp + 4 * HSZ + (size_t)(q - 1) * DFF;
    const float* wv = cw + (e ? 2 : 0) * DFF;
#pragma unroll 4
    for (int jj = 0; jj < 11; ++jj) { const int c = (jj * 64 + ln) * 4;
        f32x4 pre = *(const f32x4*)(HPp + c);
        if (has) pre += *(const f32x4*)(wv + c) * *(const f32x4*)(HGn + c);
        const f32x4 uu = *(const f32x4*)(HUp + c);
        u32x2 w; w.x = cvt_pk_bf16(silu_f(pre[0]) * uu[0], silu_f(pre[1]) * uu[1]); w.y = cvt_pk_bf16(silu_f(pre[2]) * uu[2], silu_f(pre[3]) * uu[3]);
        *(u32x2*)(ACTp + (size_t)row * DFF + c) = w; }
}
__device__ __forceinline__ int launder_v(int v) { asm volatile("" : "+v"(v)); return v; }
__device__ __forceinline__ int launder_s(int v) { asm volatile("" : "+s"(v)); return v; }
#define XB_TMO      128
#define XB_XCNT(j)  (256  + 64 * (j))
#define XB_XSUB(j)  (1280 + 64 * (j))
#define XB_XGEN(j)  (2304 + 64 * (j))
#define XB_TOP      3328
#define XB_TOPGEN   3392
#define XCD_BAR_WORDS 3456
#define XB_SPIN_CAP (1u << 20)
__device__ __forceinline__ unsigned xb_ld(unsigned* p)              { return __hip_atomic_load(p, __ATOMIC_RELAXED, __HIP_MEMORY_SCOPE_AGENT); }
__device__ __forceinline__ unsigned xb_add(unsigned* p, unsigned v) { return __hip_atomic_fetch_add(p, v, __ATOMIC_RELAXED, __HIP_MEMORY_SCOPE_AGENT); }
__device__ __forceinline__ unsigned xb_xcc_id() { return (unsigned)__builtin_amdgcn_s_getreg((3 << 11) | 20) & 0xFu; }
#define XB_SPIN(cond, bar) do { unsigned _sp = 0; while (cond) { __builtin_amdgcn_s_sleep(1); \
    if ((++_sp & 255u) == 0u) { if (xb_ld(&(bar)[XB_TMO])) break; if (_sp > XB_SPIN_CAP) { atomicAdd(&(bar)[XB_TMO], 1u); break; } } } } while (0)
__device__ __forceinline__ void xcd_barrier_complete(unsigned* bar, unsigned x, unsigned& nloc, unsigned& nx) {
    const unsigned Gn = gridDim.x * gridDim.y * gridDim.z;
    unsigned sum, cnt, mine, sp = 0u;
    for (;;) {
        sum = 0u; cnt = 0u; mine = 0u;
#pragma unroll
        for (unsigned j = 0; j < 16; ++j) { const unsigned c = xb_ld(&bar[XB_XCNT(j)]); sum += c; cnt += (c > 0u) ? 1u : 0u; mine = (j == x) ? c : mine; }
        if (sum == Gn) break;
        __builtin_amdgcn_s_sleep(1);
        if ((++sp & 255u) == 0u) { if (xb_ld(&bar[XB_TMO])) break; if (sp > XB_SPIN_CAP) { atomicAdd(&bar[XB_TMO], 1u); break; } }
    }
    nloc = mine > 0u ? mine : 1u; nx = cnt > 0u ? cnt : 1u;
}
__device__ __forceinline__ void xcd_barrier(unsigned* bar, volatile LAS unsigned* st) {
    asm volatile("s_waitcnt vmcnt(0)" ::: "memory");
    __syncthreads();
    if (threadIdx.x == 0) {
        const unsigned x = xb_xcc_id();
        __builtin_amdgcn_s_waitcnt(0);
        unsigned nloc = st[0], nx = st[1];
        if (nloc == 0u) { xcd_barrier_complete(bar, x, nloc, nx); st[0] = nloc; st[1] = nx; }
        const unsigned old = xb_add(&bar[XB_XSUB(x)], 1u);
        const unsigned gen = old / nloc;
        if (old + 1u == (gen + 1u) * nloc) {
            __builtin_amdgcn_fence(__ATOMIC_RELEASE, "agent");
            asm volatile("s_waitcnt vmcnt(0)" ::: "memory");
            const unsigned og = xb_add(&bar[XB_TOP], 1u);
            const unsigned tg = og / nx;
            if (og + 1u == (tg + 1u) * nx) xb_add(&bar[XB_TOPGEN], 1u);
            else XB_SPIN(xb_ld(&bar[XB_TOPGEN]) == tg, bar);
            __builtin_amdgcn_fence(__ATOMIC_ACQUIRE, "agent");
            xb_add(&bar[XB_XGEN(x)], 1u);
            asm volatile("s_waitcnt vmcnt(0)" ::: "memory");
        } else {
            XB_SPIN(xb_ld(&bar[XB_XGEN(x)]) == gen, bar);
            __builtin_amdgcn_fence(__ATOMIC_ACQUIRE, "agent");
            asm volatile("s_waitcnt vmcnt(0)" ::: "memory");
        }
    }
    __syncthreads();
}

__global__ void __launch_bounds__(512, 2) fwd(Params p) {
    extern __shared__ __attribute__((aligned(16))) unsigned char lds[];
    cg::grid_group grid = cg::this_grid();
#define tid (launder_v((int)threadIdx.x))
#define lane (launder_v((int)threadIdx.x) & 63)
#define wave (__builtin_amdgcn_readfirstlane(launder_v((int)threadIdx.x) >> 6))
#define G (launder_s((int)gridDim.x))
#define bx (launder_s((int)blockIdx.x))
#define vcu ((bx & 7) * (G >> 3) + (bx >> 3))
#define gw (bx * 8 + wave)
#define NGW (G * 8)
#define ws (p.ws)
    {
        volatile LAS unsigned* st_ = (volatile LAS unsigned*)((LAS unsigned char*)lds + LDS_BARST);
        if (threadIdx.x == 0) { const unsigned xc_ = xb_xcc_id(); st_[0] = 0u; st_[1] = 0u; st_[2] = xb_add((unsigned*)(ws + WS_CTL) + XB_XCNT(xc_), 1u); st_[3] = xc_; }
        __syncthreads();
    }
#define GSYNC() xcd_barrier((unsigned*)(ws + WS_CTL), (volatile LAS unsigned*)((LAS unsigned char*)lds + LDS_BARST))
    LAS unsigned char* ldsL = (LAS unsigned char*)lds;

#define x_in (p.in[0])
#define c_in (p.in[1])
#define ctx_in (p.in[2])
#define cctx_in (p.in[3])
#define w_mod (p.in[4])
#define b_mod (p.in[5])
#define MOD ((float*)(ws + WS_MOD))
#define RS ((float*)(ws + WS_RS))
#define ROPEA ((float2*)(ws + WS_ROPEA))
#define ROPEC ((float2*)(ws + WS_ROPEC))
#define W_IN0 ((bf16_t*)(ws + WS_WIN0))
#define W_UQ ((bf16_t*)(ws + WS_WUQ))
#define W_UKV ((bf16_t*)(ws + WS_WUKV))
#define W_POOL ((bf16_t*)(ws + WS_WPOOL))
#define W_OUT0 ((bf16_t*)(ws + WS_WOUT0))
#define W_GIN ((bf16_t*)(ws + WS_WGIN))
#define W_GOUT ((bf16_t*)(ws + WS_WGOUT))
#define W_UP ((bf16_t*)(ws + WS_WUP))
#define W_DOWN ((bf16_t*)(ws + WS_WDOWN))
#define Hb ((bf16_t*)(ws + WS_H))
#define X1 ((float*)(ws + WS_X1))
#define X16 ((bf16_t*)(ws + WS_X1))
#define V0 ((bf16_t*)(ws + WS_V0))
#define DP ((bf16_t*)(ws + WS_DP))
#define CAT ((bf16_t*)(ws + WS_CAT))
#define Q0 ((bf16_t*)(ws + WS_Q0))
#define K0 ((bf16_t*)(ws + WS_K0))
#define PL ((bf16_t*)(ws + WS_PL))
#define ACT ((bf16_t*)(ws + WS_ACT))
#define HALO ((float*)(ws + WS_HALO))
#define PG ((bf16_t*)(ws + WS_PG))
#define CAT1 ((bf16_t*)(ws + WS_CAT1))
#ifndef PHMASK
#define PHMASK 0xFFFFFFFFu
#endif
#ifndef DUPMASK
#define DUPMASK 0u
#endif
#define PH(k) _Pragma("unroll 1") for (int rep_ = 0; rep_ < (int)(((PHMASK >> (k)) & 1u) + ((DUPMASK >> (k)) & 1u)); ++rep_)

#define CV_I_IN0 (16 * 40)
#define CV_I_UQ (6 * 24)
#define CV_I_UKV (4 * 32)
#define CV_I_POOL (8 * 16)
#define CV_I_OUT0 (16 * 32)
#define CV_I_GIN (16 * 48)
#define CV_I_GOUT (16 * 32)
#define CV_I_UP (16 * 176)
#define CV_I_DOWN (44 * 32)
#define CV_A_END (CV_I_IN0 + CV_I_UQ + CV_I_UKV + CV_I_POOL + CV_I_OUT0)
#define CV_B_END (CV_A_END + CV_I_UP + CV_I_DOWN)
#define CV_C_END (CV_B_END + CV_I_GIN + CV_I_GOUT + CV_I_UP + CV_I_DOWN)
#define CONVERT_ITEM(it_) do { int r = (it_); LAS float* scr = (LAS float*)(ldsL + wave * 16384); const int ln_ = lane; \
        if (r < CV_I_IN0) { const int kb = r / 40, nb = r % 40; const float* w_in0 = p.in[6]; \
            tr_item([=](int k, int n) { return n < 1184 ? w_in0[(size_t)k * 1184 + n] : 0.f; }, W_IN0, 1024, kb * 64, nb * 32, scr, ln_); break; } r -= CV_I_IN0; \
        if (r < CV_I_UQ) { const int kb = r / 24, nb = r % 24; const float* g_q0 = p.in[7]; const float* w_uq = p.in[8]; \
            tr_item([=](int k, int n) { return g_q0[k] * w_uq[(size_t)k * 768 + n]; }, W_UQ, 384, kb * 64, nb * 32, scr, ln_); break; } r -= CV_I_UQ; \
        if (r < CV_I_UKV) { const int kb = r / 32, nb = r % 32; const float* g_kv0 = p.in[9]; const float* w_uk = p.in[10]; const float* w_uv = p.in[11]; \
            tr_item([=](int k, int n) { return g_kv0[k] * (n < 512 ? w_uk[(size_t)k * 512 + n] : w_uv[(size_t)k * 512 + n - 512]); }, W_UKV, 256, kb * 64, nb * 32, scr, ln_); break; } r -= CV_I_UKV; \
        if (r < CV_I_POOL) { const int kb = r / 16, nb = r % 16; const float* pool_w = p.in[12]; const float* pool_s = p.in[13]; \
            tr_item([=](int k, int n) { return ((k >> 7) == (n >> 7)) ? pool_w[(size_t)(k >> 7) * 16384 + (k & 127) * 128 + (n & 127)] * pool_s[n] : 0.f; }, W_POOL, 512, kb * 64, nb * 32, scr, ln_); break; } r -= CV_I_POOL; \
        if (r < CV_I_OUT0) { const int kb = r / 32, nb = r % 32; const float* w_out0 = p.in[14]; \
            tr_item([=](int k, int n) { return w_out0[(size_t)k * 1024 + n]; }, W_OUT0, 1024, kb * 64, nb * 32, scr, ln_); break; } r -= CV_I_OUT0; \
        if (r < CV_I_UP) { const int kb = r / 176, nb = r % 176; const float* W = p.in[19]; \
            tr_item([=](int k, int n) { return W[(size_t)k * 5632 + ((n >> 7) & 1) * DFF + (n >> 8) * 128 + (n & 127)]; }, W_UP, 1024, kb * 64, nb * 32, scr, ln_); break; } r -= CV_I_UP; \
        if (r < CV_I_DOWN) { const int kb = r / 32, nb = r % 32; const float* W = p.in[22]; \
            tr_item([=](int k, int n) { return W[(size_t)k * 1024 + n]; }, W_DOWN, DFF, kb * 64, nb * 32, scr, ln_); break; } r -= CV_I_DOWN; \
        if (r < CV_I_GIN) { const int kb = r / 48, nb = r % 48; const float* gqa_w_in = p.in[15]; \
            tr_item([=](int k, int n) { return gqa_w_in[(size_t)k * 1536 + n]; }, W_GIN, 1024, kb * 64, nb * 32, scr, ln_); break; } r -= CV_I_GIN; \
        if (r < CV_I_GOUT) { const int kb = r / 32, nb = r % 32; const float* gqa_w_out = p.in[18]; \
            tr_item([=](int k, int n) { return gqa_w_out[(size_t)k * 1024 + n]; }, W_GOUT, 1024, kb * 64, nb * 32, scr, ln_); break; } r -= CV_I_GOUT; \
        if (r < CV_I_UP) { const int kb = r / 176, nb = r % 176; const float* W = p.in[19] + (size_t)1024 * 5632; \
            tr_item([=](int k, int n) { return W[(size_t)k * 5632 + ((n >> 7) & 1) * DFF + (n >> 8) * 128 + (n & 127)]; }, W_UP + (size_t)5632 * 1024, 1024, kb * 64, nb * 32, scr, ln_); break; } r -= CV_I_UP; \
        { const int kb = r / 32, nb = r % 32; const float* W = p.in[22] + (size_t)DFF * 1024; \
            tr_item([=](int k, int n) { return W[(size_t)k * 1024 + n]; }, W_DOWN + (size_t)1024 * DFF, DFF, kb * 64, nb * 32, scr, ln_); } \
    } while (0)
#define DRAIN_CONVERT(cid_, skip_, lo, hi) do { const int c_ = (cid_), nb_ = G - (skip_);   \
        if (c_ >= (skip_)) for (int it_q = (lo) + (c_ - (skip_)) * 8 + wave; it_q < (hi); it_q += nb_ * 8) CONVERT_ITEM(it_q); } while (0)

    PH(0) {
        if (bx < 96) {
            const int layer = bx / 48, col0 = (bx % 48) * 128;
            LAS float* sv = (LAS float*)ldsL; LAS float* red = sv + 5120;
            for (int i = tid; i < 5120; i += 512) { const int v = i >> 10, k = i & 1023; const float cv = v < 4 ? c_in[v * 1024 + k] : cctx_in[k];
                sv[i] = cv / (1.0f + __expf(-cv)); }
            __syncthreads();
            const float* W = w_mod + (size_t)layer * 1024 * 6144 + col0 + 2 * lane;
            float a0[5] = {0.f, 0.f, 0.f, 0.f, 0.f}, a1[5] = {0.f, 0.f, 0.f, 0.f, 0.f};
#pragma unroll 32
            for (int kk = 0; kk < 128; ++kk) { const int k = wave * 128 + kk; const float2 w = *(const float2*)(W + (size_t)k * 6144);
#pragma unroll
                for (int v = 0; v < 5; ++v) { const float s = sv[v * 1024 + k]; a0[v] += s * w.x; a1[v] += s * w.y; } }
#pragma unroll
            for (int v = 0; v < 5; ++v) { red[(wave * 5 + v) * 128 + 2 * lane] = a0[v]; red[(wave * 5 + v) * 128 + 2 * lane + 1] = a1[v]; }
            __syncthreads();
            for (int i = tid; i < 640; i += 512) { const int v = i >> 7, cc = i & 127; float s = b_mod[layer * 6144 + col0 + cc];
#pragma unroll
                for (int w = 0; w < 8; ++w) s += red[(w * 5 + v) * 128 + cc];
                MOD[(size_t)(layer * 5 + v) * 6144 + col0 + cc] = s; }
            __syncthreads();
        }
        for (int idx = bx * 512 + tid; idx < NSEQ * 80; idx += G * 512) {
            const int t = idx / 80, j = idx % 80; const int prow = t >> 6, pcol = t & 63;
            float pos, fe;
            if (j < 16) { pos = (float)((j < 8) ? prow : pcol); fe = (float)(j & 7) * (1.0f / 8.0f); }
            else { const int jj = j - 16; pos = (float)((jj < 32) ? prow : pcol); fe = (float)(jj & 31) * (1.0f / 32.0f); }
            const float freq = exp2f(-fe * 13.287712379549449f);
            const float ang = pos * freq;
            const float kq = rintf(ang * 0.15915494309189535f);
            float rr = fmaf(-kq, 6.2831854820251465f, ang); rr = fmaf(-kq, -1.7484555e-7f, rr);
            float2 cs; cs.x = __cosf(rr); cs.y = __sinf(rr);
            if (j < 16) ROPEA[(size_t)t * 16 + j] = cs; else ROPEC[(size_t)t * 64 + (j - 16)] = cs;
        }
        DRAIN_CONVERT(bx, 96, 0, CV_A_END);
    }
    if (p.out == nullptr) grid.sync();
    GSYNC();
    {
        volatile LAS unsigned* st_ = (volatile LAS unsigned*)((LAS unsigned char*)lds + LDS_BARST);
        if (threadIdx.x == 0) {
            unsigned* bar_ = (unsigned*)(ws + WS_CTL); const unsigned Gn = gridDim.x; bool uni = (Gn % 8u) == 0u;
#pragma unroll
            for (unsigned j = 0; j < 16; ++j) { const unsigned c = xb_ld(&bar_[XB_XCNT(j)]); if (c != (j < 8u ? Gn / 8u : 0u)) uni = false; }
            const unsigned tk = st_[2], xc = st_[3], b_ = blockIdx.x;
            st_[4] = uni ? tk * 8u + xc : b_;
            st_[5] = uni ? xc * (Gn / 8u) + tk : ((Gn % 8u) == 0u ? (b_ & 7u) * (Gn >> 3) + (b_ >> 3) : b_);
        }
        __syncthreads();
    }
#define XCH_ARGS(k_) (unsigned*)(ws + WS_XSLOT), (unsigned*)(ws + WS_CTL) + CW_PANEL, 32u * (k_), (LAS unsigned char*)lds + LDS_XCH, (float*)(ws + WS_SLAB), (unsigned*)(ws + WS_CTL) + CW_SLAB, (unsigned)(k_)
#define CID ((int)__builtin_amdgcn_readfirstlane(((volatile LAS unsigned*)((LAS unsigned char*)lds + LDS_BARST))[4]))
#define VID ((int)__builtin_amdgcn_readfirstlane(((volatile LAS unsigned*)((LAS unsigned char*)lds + LDS_BARST))[5]))

    PH(1) for (int r = 2 * gw; r < RT; r += 2 * NGW) {
        const int v = r < RL ? (r >> 13) : 4; const float* xr = r < RL ? x_in + (size_t)r * DM : ctx_in + (size_t)(r - RL) * DM;
        modulate_2rows(xr, xr + DM, MOD + (size_t)(v * 6 + 0) * DM, MOD + (size_t)(v * 6 + 1) * DM, Hb + (size_t)r * DM, Hb + (size_t)(r + 1) * DM, lane);
    }
    GSYNC();

    PH(2) {
        pg8::Gemm g{Hb, W_IN0, RT, NIN0, 1024, 1024, 1024}; pg8::StaticOrder S; S.init(RT, NIN0, G, CID);
        pg8::EpiStore E{PL, NIN0};
        pg8::gemm_phase<pg8::EpiStore, pg8::StaticOrder>(ldsL, g, S, E);
    }
    GSYNC();

    PH(3) for (int r = 2 * gw; r < RT; r += 2 * NGW) {
        const bf16_t* pr = PL + (size_t)r * NIN0;
        const bool lat = r < RL;
        const int i16 = lane & 15, hq = lane >> 4, half = 1 << hq;
        const int t = lat ? (r & (NSEQ - 1)) : ((r - RL) & (NCTX - 1)); const int T = lat ? NSEQ : NCTX;
        const u32x4 a0 = *(const u32x4*)(pr + 8 * lane), a1 = *(const u32x4*)(pr + NIN0 + 8 * lane);
        u32x4 b0 = {0u, 0u, 0u, 0u}, b1 = {0u, 0u, 0u, 0u};
        if (lane < 16) { b0 = *(const u32x4*)(pr + 512 + 8 * lane); b1 = *(const u32x4*)(pr + NIN0 + 512 + 8 * lane); }
        const unsigned kw0 = *(const unsigned*)(pr + 640 + 2 * i16), kw1 = *(const unsigned*)(pr + NIN0 + 640 + 2 * i16);
        float2 cs0, cs1; cs0.x = 1.f; cs0.y = 0.f; cs1 = cs0;
        if (lat) { cs0 = ROPEA[(size_t)t * 16 + i16]; cs1 = ROPEA[(size_t)(t + 1) * 16 + i16]; }
        const bf16_t* pp = pr + 672 + 8 * lane;
        u32x4 w[17];
#pragma unroll
        for (int k = 0; k < 17; ++k) { const int dt = k - 8; const bool need = (dt >= -half) && (dt <= half) && (t + dt >= 0) && (t + dt < T);
            w[k] = (u32x4){0u, 0u, 0u, 0u}; if (need) w[k] = *(const u32x4*)(pp + dt * NIN0); }
        {
            float s0 = 0.f, s1 = 0.f, u0 = 0.f, u1 = 0.f;
#pragma unroll
            for (int e = 0; e < 4; ++e) { float lo = bf_lo(a0[e]), hi = bf_hi(a0[e]); s0 += lo * lo + hi * hi; lo = bf_lo(a1[e]); hi = bf_hi(a1[e]); s1 += lo * lo + hi * hi;
                                          lo = bf_lo(b0[e]); hi = bf_hi(b0[e]); u0 += lo * lo + hi * hi; lo = bf_lo(b1[e]); hi = bf_hi(b1[e]); u1 += lo * lo + hi * hi; }
            float q0 = lane < 48 ? s0 : 0.f, q1 = lane < 48 ? s1 : 0.f, k0 = (lane < 48 ? 0.f : s0) + u0, k1 = (lane < 48 ? 0.f : s1) + u1;
#pragma unroll
            for (int o = 1; o < 64; o <<= 1) { q0 += __shfl_xor(q0, o); q1 += __shfl_xor(q1, o); k0 += __shfl_xor(k0, o); k1 += __shfl_xor(k1, o); }
            if (lane == 0) { f32x4 rs; rs[0] = rsqrtf(q0 * (1.f / 384.f) + EPSN); rs[1] = rsqrtf(k0 * (1.f / 256.f) + EPSN); rs[2] = rsqrtf(q1 * (1.f / 384.f) + EPSN); rs[3] = rsqrtf(k1 * (1.f / 256.f) + EPSN);
                             *(f32x4*)(RS + 2 * r) = rs; }
        }
        {
            const float x0 = bf_lo(kw0), x1 = bf_hi(kw0), z0 = bf_lo(kw1), z1 = bf_hi(kw1);
            const unsigned o0 = cvt_pk_bf16(x0 * cs0.x - x1 * cs0.y, x0 * cs0.y + x1 * cs0.x), o1 = cvt_pk_bf16(z0 * cs1.x - z1 * cs1.y, z0 * cs1.y + z1 * cs1.x);
            bf16_t* kd = K0 + (size_t)r * 768 + hq * 96 + 64 + 2 * i16;
            *(unsigned*)(kd) = o0; *(unsigned*)(kd + 4 * 96) = o0; *(unsigned*)(kd + 768) = o1; *(unsigned*)(kd + 768 + 4 * 96) = o1;
        }
        {
            float acc0[8] = {0.f, 0.f, 0.f, 0.f, 0.f, 0.f, 0.f, 0.f}, acc1[8] = {0.f, 0.f, 0.f, 0.f, 0.f, 0.f, 0.f, 0.f}; float c0 = 0.f, c1 = 0.f;
#pragma unroll
            for (int k = 0; k < 17; ++k) { const int dt = k - 8; const bool val = (t + dt >= 0) && (t + dt < T);
                const bool in0 = val && (dt >= -half) && (dt < half), in1 = val && (dt >= 1 - half) && (dt <= half);
                const float m0 = in0 ? 1.f : 0.f, m1 = in1 ? 1.f : 0.f; c0 += m0; c1 += m1;
#pragma unroll
                for (int e = 0; e < 4; ++e) { const float lo = bf_lo(w[k][e]), hi = bf_hi(w[k][e]);
                    acc0[2 * e] += m0 * lo; acc0[2 * e + 1] += m0 * hi; acc1[2 * e] += m1 * lo; acc1[2 * e + 1] += m1 * hi; } }
            const float ic0 = 1.0f / c0, ic1 = 1.0f / c1;
            u32x4 d0, d1;
#pragma unroll
            for (int e = 0; e < 4; ++e) { d0[e] = cvt_pk_bf16(acc0[2 * e] * ic0 - bf_lo(w[8][e]), acc0[2 * e + 1] * ic0 - bf_hi(w[8][e]));
                                          d1[e] = cvt_pk_bf16(acc1[2 * e] * ic1 - bf_lo(w[9][e]), acc1[2 * e + 1] * ic1 - bf_hi(w[9][e])); }
            *(u32x4*)(DP + (size_t)r * 512 + 8 * lane) = d0; *(u32x4*)(DP + (size_t)(r + 1) * 512 + 8 * lane) = d1;
        }
    }
    GSYNC();

    PH(4) {
#ifndef P4SEL
#define P4SEL 7
#endif
        if constexpr (P4SEL & 1) { pg8::Gemm g{PL, W_UQ, RT, 768, 384, NIN0, 384}; pg8::StaticOrder S; S.init(RT, 768, G, CID);
          pg8::EpiQ0 E{Q0, RS};
          pg8::gemm_phase<pg8::EpiQ0, pg8::StaticOrder>(ldsL, g, S, E); }
        if constexpr (P4SEL & 2) { pg8::Gemm g{PL + 384, W_UKV, RT, 1024, 256, NIN0, 256}; pg8::StaticOrder S; S.init(RT, 1024, G, CID);
          pg8::EpiKV0 E{K0, V0, RS};
          pg8::gemm_phase<pg8::EpiKV0, pg8::StaticOrder>(ldsL, g, S, E); }
        if constexpr (P4SEL & 4) { pg8::Gemm g{DP, W_POOL, RT, 512, 512, 512, 512}; pg8::StaticOrder S; S.init(RT, 512, G, CID);
          pg8::EpiStore E{CAT + 512, DM};
          pg8::gemm_phase<pg8::EpiStore, pg8::StaticOrder>(ldsL, g, S, E); }
    }
    GSYNC();

    PH(5) {
        const float scale = 0.10206207261596577f;
        const float C = scale * 1.4426950408889634f, thr = 8.0f / scale;
        if (bx < 32) {
            const int b = bx >> 3, h = bx & 7; const size_t r0 = (size_t)RL + b * NCTX;
            att::attn_unit<6, 2>(Q0 + r0 * 768 + h * 96, 768, K0 + r0 * 768 + h * 96, K0, 768, V0 + r0 * 512 + h * 64, V0, 512,
                                 CAT + r0 * DM + h * 64, DM, NCTX, NCTX, C, thr, (char*)lds);
        }
        for (int U = VID; U < 1024; U += G) {
            const int qb = U & 31, bh = U >> 5, h = bh & 7, b = bh >> 3;
            const size_t rc = (size_t)RL + b * NCTX, rl = (size_t)b * NSEQ, rq = rl + qb * 256;
            att::attn_unit<6, 2>(Q0 + rq * 768 + h * 96, 768, K0 + rc * 768 + h * 96, K0 + rl * 768 + h * 96, 768,
                                 V0 + rc * 512 + h * 64, V0 + rl * 512 + h * 64, 512, CAT + rq * DM + h * 64, DM, NCTX + NSEQ, NCTX, C, thr, (char*)lds, ROPEA, qb * 256);
        }
    }
    GSYNC();

    PH(6) {
        pg8::Gemm g{CAT, W_OUT0, RT, 1024, 1024, 1024, 1024}; pg8::AlignedOrder S; S.init(RT, 1024, G, CID, 16);
        pg8::EpiResidMod E{x_in, ctx_in, nullptr, X16, MOD, 2, MOD, 3, Hb, nullptr, nullptr, XCH_ARGS(1)};
        pg8::gemm_phase<pg8::EpiResidMod, pg8::AlignedOrder>(ldsL, g, S, E);
        DRAIN_CONVERT(CID, 32, CV_A_END, CV_B_END);
    }
    GSYNC();

#define FFN_BLOCK(layer) do { \
        const int rows = (layer) == 0 ? RT : RL; const float* modL = MOD + (size_t)(layer) * 5 * 6144; \
        PH(8) { pg8::Gemm g{Hb, W_UP + (size_t)layer * 5632 * 1024, rows, 5632, 1024, 1024, 1024}; pg8::StaticOrder S; S.init(rows, 5632, G, CID); \
          pg8::EpiFFN E{ACT, HALO, p.in[20] + (size_t)layer * 3 * DFF, p.in[21] + (size_t)layer * DFF}; \
          pg8::gemm_phase<pg8::EpiFFN, pg8::StaticOrder>(ldsL, g, S, E); } \
        GSYNC(); \
        PH(10) { \
          { pg8::AlignedOrder S0; S0.init(rows, 1024, G, CID, 44); pg8::Unit uu_; \
            _Pragma("unroll 1") for (int ui_ = 0; S0.next(ui_, uu_); ++ui_) fix_edges(ACT, HALO, p.in[20] + (size_t)layer * 3 * DFF, 4 * uu_.pm + (wave >> 1), wave & 1, lane); \
            asm volatile("s_waitcnt vmcnt(0)" ::: "memory"); __syncthreads(); } \
          { pg8::Gemm g{ACT, W_DOWN + (size_t)layer * 1024 * DFF, rows, 1024, DFF, DFF, DFF}; pg8::AlignedOrder S; S.init(rows, 1024, G, CID, 44); \
          pg8::EpiResidMod E{nullptr, nullptr, X16, (layer) == 0 ? X16 : nullptr, modL, 5, MOD + (size_t)5 * 6144, 0, Hb, (layer) == 0 ? nullptr : p.in[23], p.out, XCH_ARGS((layer) == 0 ? 2 : 4)}; \
          pg8::gemm_phase<pg8::EpiResidMod, pg8::AlignedOrder>(ldsL, g, S, E); } \
          if ((layer) == 0) DRAIN_CONVERT(CID, 32, CV_B_END, CV_C_END); } \
        if ((layer) == 0) GSYNC(); \
    } while (0)
    FFN_BLOCK(0);
    {
        const float* modL = MOD + (size_t)5 * 6144;
            PH(12) { pg8::Gemm g{Hb, W_GIN, RT, 1536, 1024, 1024, 1024}; pg8::StaticOrder S; S.init(RT, 1536, G, CID);
              pg8::EpiQKNorm E{PG, p.in[16], p.in[17], ROPEC, (LAS unsigned char*)lds + LDS_XCH};
              pg8::gemm_phase<pg8::EpiQKNorm, pg8::StaticOrder>(ldsL, g, S, E); }
            GSYNC();
            PH(14) {
                const float scale = 0.08838834764831845f;
                const float C = scale * 1.4426950408889634f, thr = 8.0f / scale;
                for (int U = VID; U < 1024; U += G) {
                    const int qb = U & 31, bh = U >> 5, h = bh & 7, b = bh >> 3, kvh = h >> 2;
                    const size_t rc = (size_t)RL + b * NCTX, rl = (size_t)b * NSEQ, rq = rl + qb * 256;
                    att::attn_unit<8, 4>(PG + rq * 1536 + h * 128, 1536, PG + rc * 1536 + 1024 + kvh * 128, PG + rl * 1536 + 1024 + kvh * 128, 1536,
                                         PG + rc * 1536 + 1280 + kvh * 128, PG + rl * 1536 + 1280 + kvh * 128, 1536, CAT1 + rq * DM + h * 128, DM, NCTX + NSEQ, NCTX, C, thr, (char*)lds);
                }
            }
            GSYNC();
            PH(15) { pg8::Gemm g{CAT1, W_GOUT, RL, 1024, 1024, 1024, 1024}; pg8::AlignedOrder S; S.init(RL, 1024, G, CID);
              pg8::EpiResidMod E{nullptr, nullptr, X16, X16, modL, 2, modL, 3, Hb, nullptr, nullptr, XCH_ARGS(3)};
              pg8::gemm_phase<pg8::EpiResidMod, pg8::AlignedOrder>(ldsL, g, S, E); }
            GSYNC();
    }
    FFN_BLOCK(1);

}

#undef tid
#undef lane
#undef wave
#undef G
#undef bx
#undef vcu
#undef gw
#undef NGW
#undef ws
#undef X16
#undef GSYNC
#undef CID
#undef XCH_ARGS
#undef VID
#undef MOD
#undef RS
#undef x_in
#undef c_in
#undef ctx_in
#undef cctx_in
#undef w_mod
#undef b_mod
extern "C" void kernel_launch(void* const* d_in, const int* in_sizes, int n_in, void* d_out, int out_size, void* d_ws, size_t ws_size, hipStream_t stream) {
    static int grid = 0;
    if (grid == 0) {
        if (n_in != 24 || out_size != RL * DM || ws_size < WS_END) { fprintf(stderr, "kernel_launch: unexpected shapes n_in %d out %d ws %zu (need %zu)\n", n_in, out_size, ws_size, (size_t)WS_END); grid = -1; return; }
        int dev = 0, cus = 0, per_cu = 0;
        if (hipGetDevice(&dev) != hipSuccess || hipDeviceGetAttribute(&cus, hipDeviceAttributeMultiprocessorCount, dev) != hipSuccess) { grid = -1; return; }
        if (hipFuncSetAttribute((const void*)fwd, hipFuncAttributeMaxDynamicSharedMemorySize, LDS_BYTES) != hipSuccess) { fprintf(stderr, "kernel_launch: hipFuncSetAttribute failed\n"); grid = -1; return; }
        if (hipOccupancyMaxActiveBlocksPerMultiprocessor(&per_cu, (const void*)fwd, 512, LDS_BYTES) != hipSuccess || per_cu < 1) fprintf(stderr, "kernel_launch: occupancy query says %d\n", per_cu);
        (void)hipGetLastError();
        grid = cus;
    }
    if (grid < 0) return;
    Params p{};
    for (int i = 0; i < 24; ++i) p.in[i] = (const float*)d_in[i];
    p.out = (float*)d_out; p.ws = (unsigned char*)d_ws;
    if (hipMemsetAsync((char*)d_ws + WS_CTL, 0, CTL_BYTES, stream) != hipSuccess) { fprintf(stderr, "kernel_launch: memset failed\n"); return; }
    void* args[] = {&p};
    hipError_t e = hipLaunchCooperativeKernel((const void*)fwd, dim3(grid), dim3(512), args, LDS_BYTES, stream);
    if (e != hipSuccess) fprintf(stderr, "kernel_launch: cooperative launch failed: %s (grid %d)\n", hipGetErrorString(e), grid);
}
```
